# Optimizing an MI355X kernel written in HIP

```python
import jax, jax.numpy as jnp
from jax import lax
import numpy as np

D_MODEL = 2048
BATCH = 2
SEQ = 8192
DEPTH = 4

N_MIXERS = 3
BLOCK = 128
EPS = 1e-6
NEG = -1e30
ROPE_THETA = 10000.0

A_HEAD_DIM = 64
A_HEADS = D_MODEL // A_HEAD_DIM
A_KV_HEADS = A_HEADS // 8
WINDOW = 128
A_IN = (A_HEADS + 2 * A_KV_HEADS) * A_HEAD_DIM
A_OUT = A_HEADS * A_HEAD_DIM

B_HEAD_DIM = 64
B_HEADS = D_MODEL // B_HEAD_DIM
B_IN = 3 * B_HEADS * B_HEAD_DIM + B_HEADS
B_OUT = B_HEADS * B_HEAD_DIM

C_HEADS = 4
C_V_DIM = D_MODEL // C_HEADS
C_QK_DIM = C_V_DIM // 2
C_CHUNK = 64
C_IN = 2 * C_HEADS * C_QK_DIM + 2 * C_HEADS * C_V_DIM + 2 * C_HEADS
C_OUT = C_HEADS * C_V_DIM

D_FF = ((8 * D_MODEL // 3 + 255) // 256) * 256
CONV_WIDTH = 3

N_A = (DEPTH + 2) // 3
N_B = (DEPTH + 1) // 3
N_C = DEPTH // 3

kernel_name = "hybrid_swa_fox_mlstm_convffn_adaln"


def rms_norm(x, g):
    xf = x.astype(jnp.float32)
    y = xf * lax.rsqrt(jnp.mean(xf * xf, axis=-1, keepdims=True) + EPS)
    return y.astype(x.dtype) * g


def modulate(h, shift, scale):
    return h * (1 + scale[:, None, :]) + shift[:, None, :]


def rope(t, positions):
    dh = t.shape[-1]
    inv_freq = ROPE_THETA ** (-jnp.arange(0, dh, 2, dtype=jnp.float32) / dh)
    ang = positions.astype(jnp.float32)[..., None] * inv_freq
    cos, sin = jnp.cos(ang)[:, :, None, :], jnp.sin(ang)[:, :, None, :]
    t1, t2 = jnp.split(t.astype(jnp.float32), 2, axis=-1)
    out = jnp.concatenate([t1 * cos - t2 * sin, t2 * cos + t1 * sin], axis=-1)
    return out.astype(t.dtype)


def swa_sink_attention(h, w_in, sinks, w_out, positions):
    B, S, _ = h.shape
    G = A_HEADS // A_KV_HEADS
    nb = S // BLOCK
    nq, nkv = A_HEADS * A_HEAD_DIM, A_KV_HEADS * A_HEAD_DIM
    q, k, v = jnp.split(h @ w_in, [nq, nq + nkv], axis=-1)
    q = rope(q.reshape(B, S, A_HEADS, A_HEAD_DIM), positions)
    k = rope(k.reshape(B, S, A_KV_HEADS, A_HEAD_DIM), positions)
    v = v.reshape(B, S, A_KV_HEADS, A_HEAD_DIM)
    q = q.reshape(B, nb, BLOCK, A_KV_HEADS, G, A_HEAD_DIM)

    def band(t):
        t = t.reshape(B, nb, BLOCK, A_KV_HEADS, A_HEAD_DIM)
        prev = jnp.pad(t, ((0, 0), (1, 0), (0, 0), (0, 0), (0, 0)))[:, :-1]
        return jnp.concatenate([prev, t], axis=2)

    kb, vb = band(k), band(v)
    scores = jnp.einsum('bnqhgd,bnkhd->bnhgqk', q, kb).astype(jnp.float32) * (A_HEAD_DIM ** -0.5)
    qi = jnp.arange(BLOCK)[:, None]
    kj = jnp.arange(2 * BLOCK)[None, :]
    rel = qi + BLOCK - kj
    in_win = (rel >= 0) & (rel < WINDOW)
    kpos = (jnp.arange(nb)[:, None, None] - 1) * BLOCK + kj[None]
    mask = in_win[None] & (kpos >= 0)
    scores = jnp.where(mask[None, :, None, None], scores, NEG)
    sink = jnp.broadcast_to(sinks.reshape(A_KV_HEADS, G).astype(jnp.float32)[None, None, :, :, None, None],
                            scores.shape[:-1] + (1,))
    probs = jax.nn.softmax(jnp.concatenate([scores, sink], axis=-1), axis=-1)[..., :-1]
    out = jnp.einsum('bnhgqk,bnkhd->bnqhgd', probs.astype(vb.dtype), vb)
    return out.reshape(B, S, A_OUT) @ w_out


def forgetting_attention(h, w_in, f_bias, w_out):
    B, S, _ = h.shape
    nb = S // BLOCK
    HD = B_HEADS * B_HEAD_DIM
    q, k, v, f_logit = jnp.split(h @ w_in, [HD, 2 * HD, 3 * HD], axis=-1)
    q = q.reshape(B, S, B_HEADS, B_HEAD_DIM)
    k = k.reshape(B, S, B_HEADS, B_HEAD_DIM)
    v = v.reshape(B, S, B_HEADS, B_HEAD_DIM)
    log_f = jax.nn.log_sigmoid((f_logit + f_bias).astype(jnp.float32))
    F = jnp.cumsum(log_f, axis=1)
    Fk = F.transpose(0, 2, 1)
    qb = q.reshape(B, nb, BLOCK, B_HEADS, B_HEAD_DIM).transpose(1, 0, 2, 3, 4)
    Fq = F.reshape(B, nb, BLOCK, B_HEADS).transpose(1, 0, 3, 2)
    key_pos = jnp.arange(S)

    def block(args):
        qi, Fi, bi = args
        s = jnp.einsum('bqhd,bkhd->bhqk', qi, k).astype(jnp.float32) * (B_HEAD_DIM ** -0.5)
        s = s + (Fi[..., :, None] - Fk[:, :, None, :])
        q_pos = bi * BLOCK + jnp.arange(BLOCK)
        s = jnp.where((key_pos[None, :] <= q_pos[:, None])[None, None], s, NEG)
        p = jax.nn.softmax(s, axis=-1).astype(v.dtype)
        return jnp.einsum('bhqk,bkhd->bqhd', p, v)

    out = lax.map(block, (qb, Fq, jnp.arange(nb)))
    out = out.transpose(1, 0, 2, 3, 4).reshape(B, S, B_OUT)
    return out @ w_out


def mlstm(h, w_in, gate_bias, w_out):
    B, S, _ = h.shape
    L = C_CHUNK
    nc = S // L
    Hq, Hv = C_HEADS * C_QK_DIM, C_HEADS * C_V_DIM
    q, k, v, o, gates = jnp.split(h @ w_in, [Hq, 2 * Hq, 2 * Hq + Hv, 2 * Hq + 2 * Hv], axis=-1)
    f32 = jnp.float32
    q = q.astype(f32).reshape(B, S, C_HEADS, C_QK_DIM) * (C_QK_DIM ** -0.5)
    k = k.astype(f32).reshape(B, S, C_HEADS, C_QK_DIM)
    v = v.astype(f32).reshape(B, S, C_HEADS, C_V_DIM)
    gates = (gates + gate_bias).astype(f32)
    i_pre = gates[..., :C_HEADS]
    log_f = jax.nn.log_sigmoid(gates[..., C_HEADS:])

    def chunks(t):
        return t.reshape(B, nc, L, C_HEADS, t.shape[-1]).transpose(1, 0, 3, 2, 4)

    def chunks_g(t):
        return t.reshape(B, nc, L, C_HEADS).transpose(1, 0, 3, 2)

    tri = jnp.tril(jnp.ones((L, L), dtype=bool))

    def step(carry, xs):
        C, n, m = carry
        qx, kx, vx, ix, fx = xs
        b = jnp.cumsum(fx, axis=-1)
        g = b[..., -1]
        Dm = jnp.where(tri, b[..., :, None] - b[..., None, :] + ix[..., None, :], NEG)
        inter = b + m[..., None]
        m_t = jnp.maximum(inter, jnp.max(Dm, axis=-1))
        A = jnp.exp(Dm - m_t[..., None]) * jnp.einsum('bhtd,bhsd->bhts', qx, kx)
        sc = jnp.exp(inter - m_t)
        num = sc[..., None] * jnp.einsum('bhtd,bhde->bhte', qx, C) + jnp.einsum('bhts,bhse->bhte', A, vx)
        den = sc * jnp.einsum('bhtd,bhd->bht', qx, n) + jnp.sum(A, axis=-1)
        h_t = num / jnp.maximum(jnp.abs(den), jnp.exp(-m_t))[..., None]
        wlog = g[..., None] - b + ix
        m_new = jnp.maximum(g + m, jnp.max(wlog, axis=-1))
        decay = jnp.exp(g + m - m_new)
        w_s = jnp.exp(wlog - m_new[..., None])
        C_new = decay[..., None, None] * C + jnp.einsum('bhs,bhsd,bhse->bhde', w_s, kx, vx)
        n_new = decay[..., None] * n + jnp.einsum('bhs,bhsd->bhd', w_s, kx)
        return (C_new, n_new, m_new), h_t

    init = (jnp.zeros((B, C_HEADS, C_QK_DIM, C_V_DIM), f32),
            jnp.zeros((B, C_HEADS, C_QK_DIM), f32),
            jnp.zeros((B, C_HEADS), f32))
    _, hs = lax.scan(step, init, (chunks(q), chunks(k), chunks(v), chunks_g(i_pre), chunks_g(log_f)))
    hs = hs.transpose(1, 0, 3, 2, 4).reshape(B, S, C_OUT).astype(h.dtype)
    return (jax.nn.sigmoid(o) * hs) @ w_out


def conv_glu_ffn(h, w_up, conv_w, conv_b, w_down):
    S = h.shape[1]
    u = h @ w_up
    up = jnp.pad(u, ((0, 0), (CONV_WIDTH - 1, 0), (0, 0)))
    y = up[:, 0:S] * conv_w[0]
    for j in range(1, CONV_WIDTH):
        y = y + up[:, j:j + S] * conv_w[j]
    y = y + conv_b
    gate, val = jnp.split(y, 2, axis=-1)
    return (jax.nn.silu(gate) * val) @ w_down


def setup_inputs(seed: int = 0) -> dict:
    key = jax.random.key(seed)
    ks = jax.random.split(key, 24)
    f32 = jnp.float32
    nrm = lambda k, shape, s: jax.random.normal(k, shape, f32) * s
    x = nrm(ks[0], (BATCH, SEQ, D_MODEL), 1.0)
    c = nrm(ks[1], (BATCH, D_MODEL), 1.0)
    offset = jax.random.randint(ks[2], (BATCH, 1), 0, 4096, dtype=jnp.int32)
    positions = jnp.arange(SEQ, dtype=jnp.int32)[None, :] + offset
    mod_w = nrm(ks[3], (DEPTH, D_MODEL, 6 * D_MODEL), 0.5 * D_MODEL ** -0.5)
    mod_b = nrm(ks[4], (DEPTH, 6 * D_MODEL), 0.02)
    norm_g = 1.0 + nrm(ks[5], (DEPTH, 2, D_MODEL), 0.02)
    final_g = 1.0 + nrm(ks[6], (D_MODEL,), 0.02)
    a_w_in = nrm(ks[7], (N_A, D_MODEL, A_IN), D_MODEL ** -0.5)
    a_sinks = nrm(ks[8], (N_A, A_HEADS), 1.0)
    a_w_out = nrm(ks[9], (N_A, A_OUT, D_MODEL), A_OUT ** -0.5)
    b_w_in = nrm(ks[10], (N_B, D_MODEL, B_IN), D_MODEL ** -0.5)
    b_f_bias = jax.random.uniform(ks[11], (N_B, B_HEADS), f32, 1.0, 4.0)
    b_w_out = nrm(ks[12], (N_B, B_OUT, D_MODEL), B_OUT ** -0.5)
    c_w_in = nrm(ks[13], (N_C, D_MODEL, C_IN), D_MODEL ** -0.5)
    c_gate_bias = jnp.concatenate([nrm(ks[14], (N_C, C_HEADS), 0.1),
                                   jax.random.uniform(ks[15], (N_C, C_HEADS), f32, 3.0, 6.0)], axis=-1)
    c_w_out = nrm(ks[16], (N_C, C_OUT, D_MODEL), C_OUT ** -0.5)
    ffn_w_up = nrm(ks[17], (DEPTH, D_MODEL, 2 * D_FF), D_MODEL ** -0.5)
    center = jnp.zeros((CONV_WIDTH, 1), f32).at[CONV_WIDTH - 1].set(1.0)
    ffn_conv_w = center[None] + nrm(ks[18], (DEPTH, CONV_WIDTH, 2 * D_FF), 0.2)
    ffn_conv_b = nrm(ks[19], (DEPTH, 2 * D_FF), 0.02)
    ffn_w_down = nrm(ks[20], (DEPTH, D_FF, D_MODEL), D_FF ** -0.5)
    return {"x": x, "c": c, "positions": positions, "mod_w": mod_w, "mod_b": mod_b,
            "norm_g": norm_g, "final_g": final_g,
            "a_w_in": a_w_in, "a_sinks": a_sinks, "a_w_out": a_w_out,
            "b_w_in": b_w_in, "b_f_bias": b_f_bias, "b_w_out": b_w_out,
            "c_w_in": c_w_in, "c_gate_bias": c_gate_bias, "c_w_out": c_w_out,
            "ffn_w_up": ffn_w_up, "ffn_conv_w": ffn_conv_w, "ffn_conv_b": ffn_conv_b,
            "ffn_w_down": ffn_w_down}


def reference(x, c, positions, mod_w, mod_b, norm_g, final_g,
              a_w_in, a_sinks, a_w_out, b_w_in, b_f_bias, b_w_out,
              c_w_in, c_gate_bias, c_w_out, ffn_w_up, ffn_conv_w, ffn_conv_b, ffn_w_down):
    c_act = jax.nn.silu(c)
    for i in range(DEPTH):
        mod = c_act @ mod_w[i] + mod_b[i]
        sh1, sc1, g1, sh2, sc2, g2 = jnp.split(mod, 6, axis=-1)
        hm = modulate(rms_norm(x, norm_g[i, 0]), sh1, sc1)
        kind, j = i % N_MIXERS, i // N_MIXERS
        if kind == 0:
            y = swa_sink_attention(hm, a_w_in[j], a_sinks[j], a_w_out[j], positions)
        elif kind == 1:
            y = forgetting_attention(hm, b_w_in[j], b_f_bias[j], b_w_out[j])
        else:
            y = mlstm(hm, c_w_in[j], c_gate_bias[j], c_w_out[j])
        x = x + g1[:, None, :] * y
        hf = modulate(rms_norm(x, norm_g[i, 1]), sh2, sc2)
        x = x + g2[:, None, :] * conv_glu_ffn(hf, ffn_w_up[i], ffn_conv_w[i], ffn_conv_b[i], ffn_w_down[i])
    return rms_norm(x, final_g)
```

```cpp
#include <hip/hip_runtime.h>
#include <cstdio>
#include <cstdint>
namespace pg8 {
#define PG8_LAS __attribute__((address_space(3)))
typedef unsigned short bf16_t;
typedef short bf16x8 __attribute__((ext_vector_type(8)));
typedef float f32x4 __attribute__((ext_vector_type(4)));
typedef unsigned u32x4 __attribute__((ext_vector_type(4)));
constexpr int BM = 256, BK = 64, HALF = 128, HTB = HALF * BK * 2  , STAGE_BYTES = 8 * HTB, NXCD = 8, WGM = 8;

__host__ __device__ __forceinline__ int lds_byte(int r, int c) { const int st = (r >> 4) * 2 + (c >> 5), rr = r & 15, cc = c & 31, ob = rr * 64 + cc * 2; return st * 1024 + (ob ^ (((ob >> 9) & 1) << 5)); }
__host__ __device__ __forceinline__ void stage_rc(int b, int& R, int& C) { const int st = b / 1024, sb = b % 1024, swz = sb ^ (((sb >> 9) & 1) << 5); R = (st >> 1) * 16 + swz / 64; C = (st & 1) * 32 + (swz % 64) / 2; }
__host__ __device__ __forceinline__ int perm32(int rho) { const int n = rho >> 4, i = rho & 15; return 8 * (i >> 2) + 4 * n + (i & 3); }

struct Unit { int pm, pn; };
struct Gemm { const bf16_t* A; const bf16_t* Bt; int M, N, K; };

struct StaticOrder {
    int nM, nN, nwg, G, c;
    __host__ __device__ void init(int M, int N, int G_, int c_) { nM = M / BM; nN = N / BM; nwg = nM * nN; G = G_; c = c_; }
    __host__ __device__ bool next(int i, Unit& u) const {
        const long L = (long)i * G + c; if (L >= nwg) return false;
        int wgid = (int)L; { const int q = nwg / NXCD, r = nwg % NXCD, xcd = wgid % NXCD, off = wgid / NXCD; wgid = (xcd < r ? xcd * (q + 1) : r * (q + 1) + (xcd - r) * q) + off; }
        const int nig = WGM * nN, gid = wgid / nig, fm = gid * WGM, gsz = (nM - fm) < WGM ? (nM - fm) : WGM;
        u.pm = fm + ((wgid % nig) % gsz); u.pn = (wgid % nig) / gsz; return true;
    }
    __device__ __forceinline__ void a_ready(const Unit&) const {}
    __device__ __forceinline__ void done(const Unit&) const {}
};

__device__ __forceinline__ unsigned cvt_pk_bf16(float lo, float hi) { unsigned r; asm volatile("v_cvt_pk_bf16_f32 %0, %1, %2" : "=v"(r) : "v"(lo), "v"(hi)); return r; }
typedef float f32x2 __attribute__((ext_vector_type(2)));
template <class Epi, class Sched, bool ALIGN_EPI = false, bool SP2 = false>
__device__ __forceinline__ void gemm_phase(PG8_LAS unsigned char* lds, const Gemm g, const Sched& S, const Epi& E) {
    int tid_ = threadIdx.x; asm volatile("" : "+v"(tid_));
    const int tid = tid_, wid = __builtin_amdgcn_readfirstlane(tid >> 6), lane = tid & 63, wr = wid >> 2, wc = wid & 3, fr = lane & 15, fq = lane >> 4;
    const int K = g.K, nt = K / BK;
    unsigned voffA[2], voffB[2];
#pragma unroll
    for (int i = 0; i < 2; ++i) { int R, C; stage_rc(tid * 16 + i * 8192, R, C); const int Rb = Epi::PERM ? ((R & ~31) + perm32(R & 31)) : R;
        voffA[i] = (unsigned)(R * K + C) * 2u; voffB[i] = (unsigned)(Rb * K + C) * 2u; }
    const size_t kstep = (size_t)(BK * 2);
    const size_t hstep = (size_t)HALF * K * 2;
    const size_t tstep = 2 * hstep;
    const unsigned ldsw = (unsigned)wid * 1024u;
    const int aoff = lds_byte(wr * 64 + fr, fq * 8), boff = lds_byte(wc * 32 + fr, fq * 8);
#define PG8_SA(b, h) (((b) * 2 + (h)) * HTB)
#define PG8_SB(b, h) ((4 + (b) * 2 + (h)) * HTB)
#define PG8_STAGE(bufoff, gbase, voff) do { _Pragma("unroll") for (int _i = 0; _i < 2; ++_i) \
        __builtin_amdgcn_global_load_lds((const unsigned*)((const char*)(gbase) + (voff)[_i]), (PG8_LAS unsigned*)(lds + (bufoff) + ldsw + _i * 8192), 16, 0, 0); } while (0)
#define PG8_LDA(dst, b, h) do { _Pragma("unroll") for (int m = 0; m < 4; ++m) _Pragma("unroll") for (int k = 0; k < 2; ++k) dst[m][k] = *(const PG8_LAS bf16x8*)(lds + PG8_SA(b, h) + aoff + m * 2048 + k * 1024); } while (0)
#define PG8_LDB(dst, b, h) do { _Pragma("unroll") for (int n = 0; n < 2; ++n) _Pragma("unroll") for (int k = 0; k < 2; ++k) dst[n][k] = *(const PG8_LAS bf16x8*)(lds + PG8_SB(b, h) + boff + n * 2048 + k * 1024); } while (0)
#define PG8_MMA(ai, bj, At, Bt) do { __builtin_amdgcn_s_setprio(1); _Pragma("unroll") for (int m = 0; m < 4; ++m) _Pragma("unroll") for (int n = 0; n < 2; ++n) _Pragma("unroll") for (int k = 0; k < 2; ++k) \
        acc[ai][bj][m][n] = __builtin_amdgcn_mfma_f32_16x16x32_bf16(Bt[n][k], At[m][k], acc[ai][bj][m][n], 0, 0, 0); __builtin_amdgcn_s_setprio(0); } while (0)
#define PG8_WAIT_V(n) asm volatile("s_waitcnt vmcnt(" #n ")" ::: "memory")
#define PG8_WAIT_L(n) asm volatile("s_waitcnt lgkmcnt(" #n ")" ::: "memory")
#define PG8_BAR __builtin_amdgcn_s_barrier()
#define PG8_SCHED __builtin_amdgcn_sched_barrier(0)
    Unit cur, nxt; int ui = 0;
    if (!S.next(0, cur)) return;
    f32x4 acc[2][2][4][2];
#pragma unroll
    for (int a = 0; a < 2; ++a)
#pragma unroll
        for (int b = 0; b < 2; ++b)
#pragma unroll
            for (int m = 0; m < 4; ++m)
#pragma unroll
                for (int n = 0; n < 2; ++n) acc[a][b][m][n] = (f32x4){0.f, 0.f, 0.f, 0.f};
    bf16x8 At[4][2], B0[2][2], B1[2][2];
    const char* cA = (const char*)g.A + (size_t)cur.pm * tstep; const char* cB = (const char*)g.Bt + (size_t)cur.pn * tstep;
    S.a_ready(cur);
    if constexpr (SP2) {
        PG8_STAGE(PG8_SB(0, 0), cB, voffB); PG8_STAGE(PG8_SB(0, 1), cB + hstep, voffB); PG8_STAGE(PG8_SA(0, 0), cA, voffA); PG8_STAGE(PG8_SA(0, 1), cA + hstep, voffA);
        if (wr == 1) PG8_BAR;
        PG8_WAIT_V(2); PG8_BAR;
        PG8_STAGE(PG8_SB(1, 0), cB + kstep, voffB); PG8_STAGE(PG8_SA(1, 0), cA + kstep, voffA); PG8_STAGE(PG8_SB(1, 1), cB + hstep + kstep, voffB);
        PG8_WAIT_V(6); PG8_BAR;
    } else {
        PG8_STAGE(PG8_SB(0, 0), cB, voffB); PG8_STAGE(PG8_SA(0, 0), cA, voffA); PG8_STAGE(PG8_SB(0, 1), cB + hstep, voffB); PG8_STAGE(PG8_SA(0, 1), cA + hstep, voffA);
        if (wr == 1) PG8_BAR;
        PG8_WAIT_V(4); PG8_BAR;
        PG8_STAGE(PG8_SB(1, 0), cB + kstep, voffB); PG8_STAGE(PG8_SA(1, 0), cA + kstep, voffA); PG8_STAGE(PG8_SB(1, 1), cB + hstep + kstep, voffB);
        PG8_WAIT_V(6); PG8_BAR;
    }
    for (;;) {
        const bool has_next = S.next(ui + 1, nxt);
        const char* nA = has_next ? (const char*)g.A + (size_t)nxt.pm * tstep : cA; const char* nB = has_next ? (const char*)g.Bt + (size_t)nxt.pn * tstep : cB;
        for (int t = 0; t < nt; t += 2) {
            const bool last = (t == nt - 2);
            const char* a1 = cA + (size_t)(t + 1) * kstep;
            const char* a2 = last ? nA : cA + (size_t)(t + 2) * kstep; const char* b2 = last ? nB : cB + (size_t)(t + 2) * kstep;
            const char* a3 = a2 + kstep; const char* b3 = b2 + kstep;
            if (last && has_next) S.a_ready(nxt);
            if constexpr (SP2) {
            PG8_LDB(B0, 0, 0); PG8_LDB(B1, 0, 1); PG8_SCHED; PG8_LDA(At, 0, 0); PG8_STAGE(PG8_SA(1, 1), a1 + hstep, voffA);
            PG8_WAIT_V(8); PG8_WAIT_L(0); PG8_BAR; PG8_MMA(0, 0, At, B0); PG8_MMA(0, 1, At, B1); PG8_BAR; PG8_SCHED;
            PG8_LDA(At, 0, 1); PG8_STAGE(PG8_SB(0, 0), b2, voffB); PG8_STAGE(PG8_SB(0, 1), b2 + hstep, voffB); PG8_STAGE(PG8_SA(0, 0), a2, voffA);
            PG8_WAIT_V(8); PG8_WAIT_L(0); PG8_BAR; PG8_MMA(1, 0, At, B0); PG8_MMA(1, 1, At, B1); PG8_BAR; PG8_SCHED;
            PG8_LDB(B0, 1, 0); PG8_LDB(B1, 1, 1); PG8_SCHED; PG8_LDA(At, 1, 0); PG8_STAGE(PG8_SA(0, 1), a2 + hstep, voffA);
            PG8_WAIT_V(8); PG8_WAIT_L(0); PG8_BAR; PG8_MMA(0, 0, At, B0); PG8_MMA(0, 1, At, B1); PG8_BAR; PG8_SCHED;
            PG8_LDA(At, 1, 1); PG8_STAGE(PG8_SB(1, 0), b3, voffB); PG8_STAGE(PG8_SB(1, 1), b3 + hstep, voffB); PG8_STAGE(PG8_SA(1, 0), a3, voffA);
            PG8_WAIT_V(8); PG8_WAIT_L(0); PG8_BAR; PG8_MMA(1, 0, At, B0); PG8_MMA(1, 1, At, B1); PG8_BAR; PG8_SCHED;
            } else {
            PG8_LDB(B0, 0, 0); PG8_SCHED; PG8_LDA(At, 0, 0); PG8_STAGE(PG8_SA(1, 1), a1 + hstep, voffA);
            PG8_WAIT_L(8); PG8_BAR; PG8_WAIT_L(0); PG8_MMA(0, 0, At, B0); PG8_BAR; PG8_SCHED;
            PG8_LDB(B1, 0, 1); PG8_STAGE(PG8_SB(0, 0), b2, voffB);
            PG8_BAR; PG8_WAIT_L(0); PG8_MMA(0, 1, At, B1); PG8_BAR;
            PG8_LDA(At, 0, 1); PG8_STAGE(PG8_SA(0, 0), a2, voffA);
            PG8_BAR; PG8_WAIT_L(0); PG8_MMA(1, 0, At, B0); PG8_BAR; PG8_SCHED;
            PG8_STAGE(PG8_SB(0, 1), b2 + hstep, voffB);
            PG8_WAIT_V(6); PG8_BAR; PG8_MMA(1, 1, At, B1); PG8_BAR;
            PG8_LDB(B0, 1, 0); PG8_SCHED; PG8_LDA(At, 1, 0); PG8_STAGE(PG8_SA(0, 1), a2 + hstep, voffA);
            PG8_WAIT_L(8); PG8_BAR; PG8_WAIT_L(0); PG8_MMA(0, 0, At, B0); PG8_BAR; PG8_SCHED;
            PG8_LDB(B1, 1, 1); PG8_STAGE(PG8_SB(1, 0), b3, voffB);
            PG8_BAR; PG8_WAIT_L(0); PG8_MMA(0, 1, At, B1); PG8_BAR;
            PG8_LDA(At, 1, 1); PG8_STAGE(PG8_SA(1, 0), a3, voffA);
            PG8_BAR; PG8_WAIT_L(0); PG8_MMA(1, 0, At, B0); PG8_BAR; PG8_SCHED;
            PG8_STAGE(PG8_SB(1, 1), b3 + hstep, voffB);
            PG8_WAIT_V(6); PG8_BAR; PG8_MMA(1, 1, At, B1); PG8_BAR;
            }
        }
        if constexpr (ALIGN_EPI) { if (wr == 0) PG8_BAR; }
        if constexpr (!Epi::AFTER_DRAIN) { E(acc, cur, wr, wc, fr, fq); S.done(cur); }
        if (!has_next) break;
#pragma unroll
        for (int a = 0; a < 2; ++a)
#pragma unroll
            for (int b = 0; b < 2; ++b)
#pragma unroll
                for (int m = 0; m < 4; ++m)
#pragma unroll
                    for (int n = 0; n < 2; ++n) acc[a][b][m][n] = (f32x4){0.f, 0.f, 0.f, 0.f};
        cur = nxt; cA = nA; cB = nB; ++ui;
        if constexpr (ALIGN_EPI) { if (wr == 1) PG8_BAR; }
    }
    PG8_WAIT_V(0);
    if constexpr (!ALIGN_EPI) { if (wr == 0) PG8_BAR; }
    PG8_BAR;
    if constexpr (Epi::AFTER_DRAIN) { E.fused(acc, cur, wr, wc, fr, fq, lds, wid, lane); S.done(cur); }
#undef PG8_SA
#undef PG8_SB
#undef PG8_STAGE
#undef PG8_LDA
#undef PG8_LDB
#undef PG8_MMA
#undef PG8_WAIT_V
#undef PG8_WAIT_L
#undef PG8_BAR
#undef PG8_SCHED
}
typedef unsigned u32x2 __attribute__((ext_vector_type(2)));
__device__ __forceinline__ float log_sigmoid_f(float x) { return fminf(x, 0.f) - log1pf(__expf(-fabsf(x))); }
__device__ __forceinline__ void st_bf16x8(bf16_t* p, f32x4 v0, f32x4 v1) { u32x4 w; w.x = cvt_pk_bf16(v0[0], v0[1]); w.y = cvt_pk_bf16(v0[2], v0[3]); w.z = cvt_pk_bf16(v1[0], v1[1]); w.w = cvt_pk_bf16(v1[2], v1[3]); *(u32x4*)p = w; }
template <int KIND> struct EpiIn {
    static constexpr bool PERM = true, AFTER_DRAIN = false;
    bf16_t* Y; int ldy; const float* rc; const float* rs; float* G0; float* G1; const float* gbias;
    __device__ __forceinline__ void operator()(const f32x4 (&acc)[2][2][4][2], const Unit& u, int wr, int wc, int fr, int fq) const {
        const int row0 = u.pm * BM + wr * 64 + fr, ct = u.pn * BM + wc * 32 + 8 * fq;
        if (KIND != 0 && u.pn == 24) {
            if (wc == 0) {
#pragma unroll
                for (int ai = 0; ai < 2; ++ai)
#pragma unroll
                    for (int m = 0; m < 4; ++m) { const int row = row0 + ai * HALF + m * 16; const f32x4 v0 = acc[ai][0][m][0], v1 = acc[ai][0][m][1];
                        if (KIND == 1) { f32x4 a, b;
#pragma unroll
                            for (int e = 0; e < 4; ++e) { a[e] = log_sigmoid_f(v0[e] + gbias[8 * fq + e]); b[e] = log_sigmoid_f(v1[e] + gbias[8 * fq + 4 + e]); }
                            *(f32x4*)(G0 + (size_t)row * 32 + 8 * fq) = a; *(f32x4*)(G0 + (size_t)row * 32 + 8 * fq + 4) = b; }
                        else if (fq == 0) { f32x4 a, b;
#pragma unroll
                            for (int e = 0; e < 4; ++e) { a[e] = v0[e] + gbias[e]; b[e] = log_sigmoid_f(v1[e] + gbias[4 + e]); }
                            *(f32x4*)(G0 + (size_t)row * 4) = a; *(f32x4*)(G1 + (size_t)row * 4) = b; } }
            }
            return;
        }
        float sc = 1.f; if (KIND == 1 && u.pn < 8) sc = 0.125f * 1.4426950408889634f; if (KIND == 2 && u.pn < 4) sc = 0.0625f;
        const bool rope = (KIND == 0) && (u.pn < 9); const int j4 = 4 * (4 * (wc & 1) + fq);
#pragma unroll
        for (int ai = 0; ai < 2; ++ai)
#pragma unroll
            for (int m = 0; m < 4; ++m) { const int row = row0 + ai * HALF + m * 16; bf16_t* rowp = Y + (size_t)row * ldy + ct;
                f32x4 c4 = {1.f, 1.f, 1.f, 1.f}, s4 = {0.f, 0.f, 0.f, 0.f};
                if (rope) { c4 = *(const f32x4*)(rc + (size_t)row * 32 + j4); s4 = *(const f32x4*)(rs + (size_t)row * 32 + j4); }
#pragma unroll
                for (int bj = 0; bj < 2; ++bj) { f32x4 v0 = acc[ai][bj][m][0], v1 = acc[ai][bj][m][1];
                    if (KIND == 0) { const f32x4 o0 = v0 * c4 - v1 * s4, o1 = v1 * c4 + v0 * s4; v0 = o0; v1 = o1; } else { v0 = v0 * sc; v1 = v1 * sc; }
                    st_bf16x8(rowp + bj * HALF, v0, v1); } }
    }
};
struct EpiPlain {
    static constexpr bool PERM = true, AFTER_DRAIN = false;
    bf16_t* Y; int ldy;
    __device__ __forceinline__ void operator()(const f32x4 (&acc)[2][2][4][2], const Unit& u, int wr, int wc, int fr, int fq) const {
        const int row0 = u.pm * BM + wr * 64 + fr, ct = u.pn * BM + wc * 32 + 8 * fq;
#pragma unroll
        for (int ai = 0; ai < 2; ++ai)
#pragma unroll
            for (int m = 0; m < 4; ++m) { bf16_t* rowp = Y + (size_t)(row0 + ai * HALF + m * 16) * ldy + ct;
#pragma unroll
                for (int bj = 0; bj < 2; ++bj) st_bf16x8(rowp + bj * HALF, acc[ai][bj][m][0], acc[ai][bj][m][1]); }
    }
};
struct EpiRes {
    static constexpr bool PERM = false, AFTER_DRAIN = false;
    const float* base; float* out; const float* gate; int gstride;
    __device__ __forceinline__ void operator()(const f32x4 (&acc)[2][2][4][2], const Unit& u, int wr, int wc, int fr, int fq) const {
        const float* g = gate + (u.pm >= 32 ? gstride : 0);
        const int row0 = u.pm * BM + wr * 64 + fr, col0 = u.pn * BM + wc * 32 + 4 * fq;
#pragma unroll
        for (int bj = 0; bj < 2; ++bj)
#pragma unroll
            for (int n = 0; n < 2; ++n) { const int col = col0 + bj * HALF + n * 16; const f32x4 gv = *(const f32x4*)(g + col);
#pragma unroll
                for (int ai = 0; ai < 2; ++ai)
#pragma unroll
                    for (int m = 0; m < 4; ++m) { const size_t off = (size_t)(row0 + ai * HALF + m * 16) * 2048 + col;
                        *(f32x4*)(out + off) = *(const f32x4*)(base + off) + gv * acc[ai][bj][m][n]; } }
    }
};
}
#define GAS __attribute__((address_space(1)))
#define LAS __attribute__((address_space(3)))
typedef unsigned short bf16;
typedef unsigned v4u __attribute__((ext_vector_type(4)));
typedef float f32x4 __attribute__((ext_vector_type(4)));
typedef short bf16x8 __attribute__((ext_vector_type(8)));
typedef GAS unsigned gu32;
typedef GAS unsigned long long gu64;
#define RLX_AGENT __ATOMIC_RELAXED, __HIP_MEMORY_SCOPE_AGENT
#define LDS_WAIT() asm volatile("s_waitcnt lgkmcnt(0)" ::: "memory")
#define VM_WAIT() asm volatile("s_waitcnt vmcnt(0)" ::: "memory")
__device__ __forceinline__ unsigned long long rt() { return __builtin_amdgcn_s_memrealtime(); }
__device__ __forceinline__ unsigned f2bf(float f) { unsigned u = __builtin_bit_cast(unsigned, f); return (u + 0x7fffu + ((u >> 16) & 1u)) >> 16; }
__device__ __forceinline__ unsigned pk2(float lo, float hi) { return f2bf(lo) | (f2bf(hi) << 16); }

#define XB_TMO      128
#define XB_XCNT(j)  (256  + 64 * (j))
#define XB_XSUB(j)  (1280 + 64 * (j))
#define XB_XGEN(j)  (2304 + 64 * (j))
#define XB_TOP      3328
#define XB_TOPGEN   3392
#define XCD_BAR_WORDS 3456
#define XB_SPIN_CAP (1u << 18)

__device__ __forceinline__ unsigned xb_ld(unsigned* p)              { return __hip_atomic_load(p, __ATOMIC_RELAXED, __HIP_MEMORY_SCOPE_AGENT); }
__device__ __forceinline__ unsigned xb_add(unsigned* p, unsigned v) { return __hip_atomic_fetch_add(p, v, __ATOMIC_RELAXED, __HIP_MEMORY_SCOPE_AGENT); }
__device__ __forceinline__ unsigned xb_xcc_id() { return (unsigned)__builtin_amdgcn_s_getreg((3 << 11) | 20) & 0xFu; }
#define XB_SPIN(cond, bar) do { unsigned _sp = 0; while (cond) { __builtin_amdgcn_s_sleep(1); \
    if ((++_sp & 255u) == 0u) { if (xb_ld(&(bar)[XB_TMO])) break; if (_sp > XB_SPIN_CAP) { atomicAdd(&(bar)[XB_TMO], 1u); break; } } } } while (0)

struct XcdBarrier {
    unsigned* bar; unsigned x;
    volatile LAS unsigned* st;
};

__device__ __forceinline__ XcdBarrier xcd_barrier_post(unsigned* bar, volatile LAS unsigned* st) {
    XcdBarrier b; b.bar = bar; b.x = xb_xcc_id(); b.st = st;
    if (threadIdx.x == 0) (void)xb_add(&bar[XB_XCNT(b.x)], 1u);
    return b;
}
__device__ __forceinline__ void xcd_barrier_complete(unsigned* bar, unsigned x, unsigned& nloc, unsigned& nx) {
    const unsigned G = gridDim.x * gridDim.y * gridDim.z;
    unsigned sum, cnt, mine, sp = 0u;
    for (;;) {
        sum = 0u; cnt = 0u; mine = 0u;
#pragma unroll
        for (unsigned j = 0; j < 16; ++j) { const unsigned c = xb_ld(&bar[XB_XCNT(j)]); sum += c; cnt += (c > 0u) ? 1u : 0u; mine = (j == x) ? c : mine; }
        if (sum == G) break;
        __builtin_amdgcn_s_sleep(1);
        if ((++sp & 255u) == 0u) { if (xb_ld(&bar[XB_TMO])) break; if (sp > XB_SPIN_CAP) { atomicAdd(&bar[XB_TMO], 1u); break; } }
    }
    nloc = mine > 0u ? mine : 1u; nx = cnt > 0u ? cnt : 1u;
}

__device__ __forceinline__ void xcd_barrier(const XcdBarrier& b) {
    asm volatile("s_waitcnt vmcnt(0)" ::: "memory");
    __syncthreads();
    if (threadIdx.x == 0) {
        unsigned* bar = b.bar;
        __builtin_amdgcn_s_waitcnt(0);
        unsigned nloc = b.st[0], nx = b.st[1];
        if (nloc == 0u) { xcd_barrier_complete(bar, b.x, nloc, nx); b.st[0] = nloc; b.st[1] = nx; }
        const unsigned old = xb_add(&bar[XB_XSUB(b.x)], 1u);
        const unsigned gen = old / nloc;
        if (old + 1u == (gen + 1u) * nloc) {
            __builtin_amdgcn_fence(__ATOMIC_RELEASE, "agent");
            asm volatile("s_waitcnt vmcnt(0)" ::: "memory");
            const unsigned og = xb_add(&bar[XB_TOP], 1u);
            const unsigned tg = og / nx;
            if (og + 1u == (tg + 1u) * nx) xb_add(&bar[XB_TOPGEN], 1u);
            else XB_SPIN(xb_ld(&bar[XB_TOPGEN]) == tg, bar);
            __builtin_amdgcn_fence(__ATOMIC_ACQUIRE, "agent");
            xb_add(&bar[XB_XGEN(b.x)], 1u);
            asm volatile("s_waitcnt vmcnt(0)" ::: "memory");
        } else {
            XB_SPIN(xb_ld(&bar[XB_XGEN(b.x)]) == gen, bar);
            __builtin_amdgcn_fence(__ATOMIC_ACQUIRE, "agent");
            asm volatile("s_waitcnt vmcnt(0)" ::: "memory");
        }
    }
    __syncthreads();
}
constexpr int NWAVES = 8;
constexpr int BATCH = 2, SEQ = 8192, DM = 2048, M = BATCH * SEQ, DFF = 5632, NUP = 2 * DFF, NL = 4;
constexpr int A_IN = 2560, B_IN = 6176, C_IN = 6152, BC_PAD = 6400, YLD = 6144, MODN = 6 * DM;
constexpr float LOG2E = 1.4426950408889634f;
constexpr size_t MiB = 1u << 20;
constexpr size_t WS_CTL = 0, CTL_ZERO_BYTES = 1 * MiB;
constexpr size_t WS_MODV = 1 * MiB, WS_RC = 2 * MiB, WS_RS = 4 * MiB, WS_LF = 6 * MiB, WS_FT = 8 * MiB, WS_GI = 10 * MiB, WS_LFC = 11 * MiB, WS_FTC = 12 * MiB;
constexpr size_t WS_WAIN = 16 * MiB, WS_WBIN = 36 * MiB, WS_WCIN = 61 * MiB, WS_WOUT = 86 * MiB, WS_WUP = 118 * MiB, WS_WDN = 294 * MiB;
constexpr size_t WS_X1 = 382 * MiB, WS_HN = 510 * MiB, WS_Y = 574 * MiB, WS_AO = 766 * MiB, WS_ACT = 830 * MiB, WS_U = 1006 * MiB, WS_END = 1358 * MiB;
constexpr int CW_TMO = 0, CW_BAR = 4096;
constexpr int RING_OFF = 0, RING_BYTES = 131072, LDSCTL_OFF = RING_BYTES, MISC_OFF = LDSCTL_OFF + 320, LDS_BYTES = 147456;
struct Frame {
    LAS unsigned char* lds; volatile LAS unsigned* MISC;
    int tid, lane, wave, vcu, G, bx;
};
__device__ __forceinline__ float wave_sum(float v) {
#pragma unroll
    for (int o = 1; o < 64; o <<= 1) v += __shfl_xor(v, o);
    return v;
}
__device__ __forceinline__ float bf_lo(unsigned u) { return __uint_as_float(u << 16); }
__device__ __forceinline__ float bf_hi(unsigned u) { return __uint_as_float(u & 0xffff0000u); }
__device__ __forceinline__ float dot8(v4u a, v4u b) {
    float s = bf_lo(a.x) * bf_lo(b.x); s += bf_hi(a.x) * bf_hi(b.x); s += bf_lo(a.y) * bf_lo(b.y); s += bf_hi(a.y) * bf_hi(b.y);
    s += bf_lo(a.z) * bf_lo(b.z); s += bf_hi(a.z) * bf_hi(b.z); s += bf_lo(a.w) * bf_lo(b.w); s += bf_hi(a.w) * bf_hi(b.w); return s;
}
template <int MAP> __device__ __forceinline__ int map_col(int n) {
    if (MAP == 1) { if (n < 2304) { const int hb = n & ~63, d = n & 63; const int p = (d < 32) ? ((d >> 2) * 8 + (d & 3)) : (((d - 32) >> 2) * 8 + 4 + (d & 3)); return hb + p; } return n; }
    return n;
}
template <int MAP> __device__ __forceinline__ void p0_transpose_item(const float* W, int K, int Nsrc, int Npad, bf16* WT, LAS float* scr, int item, int lane) {
    const int nblk = Npad / 32, kb = item / nblk, nb = item % nblk, k0 = 64 * kb, n0 = 32 * nb;
    const int nn = n0 + (lane & 31); const bool ok = nn < Nsrc;
#pragma unroll 8
    for (int i = 0; i < 32; ++i) { const int kk = 2 * i + (lane >> 5); scr[kk * 33 + (lane & 31)] = ok ? W[(size_t)(k0 + kk) * Nsrc + nn] : 0.f; }
    LDS_WAIT(); asm volatile("" ::: "memory");
    const int c = lane & 7;
#pragma unroll
    for (int j = 0; j < 4; ++j) { const int n = (lane >> 3) + 8 * j; const LAS float* s = scr + (8 * c) * 33 + n;
        v4u o; o.x = pk2(s[0 * 33], s[1 * 33]); o.y = pk2(s[2 * 33], s[3 * 33]); o.z = pk2(s[4 * 33], s[5 * 33]); o.w = pk2(s[6 * 33], s[7 * 33]);
        *(GAS v4u*)(WT + (size_t)map_col<MAP>(n0 + n) * K + k0 + 8 * c) = o; }
    LDS_WAIT(); asm volatile("" ::: "memory");
}
struct Ptrs {
    const float *x, *c; const int* pos; const float *mod_w, *mod_b, *norm_g, *final_g, *a_w_in, *a_sinks, *a_w_out, *b_w_in, *b_f_bias, *b_w_out, *c_w_in, *c_gate_bias, *c_w_out, *w_up, *conv_w, *conv_b, *w_dn;
    float* out; unsigned char* ws;
};
__device__ __forceinline__ void p0_prologue(Frame& F, const Ptrs& P) {
    unsigned char* ws = P.ws;
    {
        LAS float* scr = (LAS float*)(F.lds + RING_OFF + F.wave * 16384);
        const int gw = F.vcu * NWAVES + F.wave, NGW = F.G * NWAVES;
        constexpr int I_A = (DM / 64) * (A_IN / 32), I_BC = (DM / 64) * (BC_PAD / 32), I_O = (DM / 64) * (DM / 32), I_U = (DM / 64) * (NUP / 32), I_D = (DFF / 64) * (DM / 32);
        constexpr int NITEMS = 2 * I_A + 2 * I_BC + 4 * I_O + 4 * I_U + 4 * I_D;
        for (int it = gw; it < NITEMS; it += NGW) {
            int r = it;
            if (r < 2 * I_A) { const int j = r / I_A; p0_transpose_item<1>(P.a_w_in + (size_t)j * DM * A_IN, DM, A_IN, A_IN, (bf16*)(ws + WS_WAIN) + (size_t)j * A_IN * DM, scr, r % I_A, F.lane); continue; } r -= 2 * I_A;
            if (r < I_BC) { p0_transpose_item<0>(P.b_w_in, DM, B_IN, BC_PAD, (bf16*)(ws + WS_WBIN), scr, r, F.lane); continue; } r -= I_BC;
            if (r < I_BC) { p0_transpose_item<0>(P.c_w_in, DM, C_IN, BC_PAD, (bf16*)(ws + WS_WCIN), scr, r, F.lane); continue; } r -= I_BC;
            if (r < 4 * I_O) { const int l = r / I_O, kind = l % 3, j = l / 3; const float* src = (kind == 0 ? P.a_w_out : kind == 1 ? P.b_w_out : P.c_w_out) + (size_t)j * DM * DM;
                p0_transpose_item<0>(src, DM, DM, DM, (bf16*)(ws + WS_WOUT) + (size_t)l * DM * DM, scr, r % I_O, F.lane); continue; } r -= 4 * I_O;
            if (r < 4 * I_U) { const int l = r / I_U; p0_transpose_item<0>(P.w_up + (size_t)l * DM * NUP, DM, NUP, NUP, (bf16*)(ws + WS_WUP) + (size_t)l * NUP * DM, scr, r % I_U, F.lane); continue; } r -= 4 * I_U;
            { const int l = r / I_D; p0_transpose_item<0>(P.w_dn + (size_t)l * DFF * DM, DFF, DM, DM, (bf16*)(ws + WS_WDN) + (size_t)l * DM * DFF, scr, r % I_D, F.lane); }
        }
    }
    __syncthreads();
    {
        LAS float* ca = (LAS float*)(F.lds);
        LAS float* red = ca + 2 * DM;
        for (int i = F.tid; i < 2 * DM; i += 512) { const float v = P.c[i]; ca[i] = v / (1.f + __expf(-v)); }
        __syncthreads();
        const int ks = F.tid >> 6, cg = F.tid & 63;
        for (int u = F.vcu; u < NL * (MODN / 256); u += F.G) {
            const int l = u / (MODN / 256), n0 = (u % (MODN / 256)) * 256 + 4 * cg;
            const float* wp = P.mod_w + ((size_t)l * DM + ks * 256) * MODN + n0;
            f32x4 a0 = {0.f, 0.f, 0.f, 0.f}, a1 = a0;
#pragma unroll 8
            for (int k = 0; k < 256; ++k) { const f32x4 w = *(const GAS f32x4*)(wp + (size_t)k * MODN); a0 += w * ca[ks * 256 + k]; a1 += w * ca[DM + ks * 256 + k]; }
            __syncthreads();
            *(LAS f32x4*)(red + (ks * 64 + cg) * 8) = a0; *(LAS f32x4*)(red + (ks * 64 + cg) * 8 + 4) = a1;
            __syncthreads();
            if (F.tid < 128) { const int b = F.tid >> 6; f32x4 s = *(const GAS f32x4*)(P.mod_b + (size_t)l * MODN + n0);
#pragma unroll
                for (int q = 0; q < 8; ++q) s += *(LAS f32x4*)(red + (q * 64 + cg) * 8 + 4 * b);
                *(GAS f32x4*)((float*)(ws + WS_MODV) + (size_t)(l * 2 + b) * MODN + n0) = s; }
        }
    }
    {
        float* RC = (float*)(ws + WS_RC); float* RS = (float*)(ws + WS_RS);
        for (int i = F.vcu * 512 + F.tid; i < M * 32; i += F.G * 512) { const int m = i >> 5, f = i & 31;
            const float inv = powf(10000.f, -(float)(2 * f) / 64.f); const float ang = (float)P.pos[m] * inv; float sv, cv; sincosf(ang, &sv, &cv); RC[i] = cv; RS[i] = sv; }
    }
    __syncthreads();
}
__device__ __forceinline__ void norm_phase(Frame& F, const float* xin, const float* g, const float* modp, int sub, bf16* HN) {
    const int gw = F.vcu * NWAVES + F.wave, NGW = F.G * NWAVES;
    for (int m = gw; m < M; m += NGW) {
        const GAS f32x4* xr = (const GAS f32x4*)(xin + (size_t)m * DM) + F.lane;
        f32x4 v[8]; float s = 0.f;
#pragma unroll
        for (int j = 0; j < 8; ++j) { v[j] = xr[64 * j]; s += (v[j].x * v[j].x + v[j].y * v[j].y) + (v[j].z * v[j].z + v[j].w * v[j].w); }
        const float rstd = 1.f / sqrtf(wave_sum(s) * (1.f / DM) + 1e-6f);
        const float* mp = modp + (m >= SEQ ? MODN : 0) + sub * 3 * DM;
        GAS unsigned long long* o8 = (GAS unsigned long long*)(HN + (size_t)m * DM) + F.lane;
#pragma unroll
        for (int j = 0; j < 8; ++j) { const int col = 4 * F.lane + 256 * j;
            const f32x4 gg = *(const GAS f32x4*)(g + col), sh = *(const GAS f32x4*)(mp + col), sc = *(const GAS f32x4*)(mp + DM + col);
            const f32x4 y = (v[j] * rstd) * gg * (sc + 1.f) + sh;
            o8[64 * j] = (unsigned long long)pk2(y.x, y.y) | ((unsigned long long)pk2(y.z, y.w) << 32); }
    }
}
__device__ __forceinline__ void final_norm_phase(Frame& F, const float* xin, const float* g, float* out) {
    const int gw = F.vcu * NWAVES + F.wave, NGW = F.G * NWAVES;
    for (int m = gw; m < M; m += NGW) {
        const GAS f32x4* xr = (const GAS f32x4*)(xin + (size_t)m * DM) + F.lane;
        f32x4 v[8]; float s = 0.f;
#pragma unroll
        for (int j = 0; j < 8; ++j) { v[j] = xr[64 * j]; s += (v[j].x * v[j].x + v[j].y * v[j].y) + (v[j].z * v[j].z + v[j].w * v[j].w); }
        const float rstd = 1.f / sqrtf(wave_sum(s) * (1.f / DM) + 1e-6f);
        GAS f32x4* orow = (GAS f32x4*)(out + (size_t)m * DM) + F.lane;
#pragma unroll
        for (int j = 0; j < 8; ++j) { const f32x4 gg = *(const GAS f32x4*)(g + 4 * F.lane + 256 * j); orow[64 * j] = (v[j] * rstd) * gg; }
    }
}
__device__ __forceinline__ void scan_phase(Frame& F, const float* LF, int NH, float* Ft) {
    const int gw = F.vcu * NWAVES + F.wave, NGW = F.G * NWAVES;
    for (int sq = gw; sq < BATCH * NH; sq += NGW) {
        const int b = sq / NH, h = sq % NH;
        const float* src = LF + ((size_t)b * SEQ + F.lane * 128) * NH + h;
        float tot = 0.f;
        for (int i = 0; i < 128; ++i) tot += src[(size_t)i * NH];
        float inc = tot;
#pragma unroll
        for (int o = 1; o < 64; o <<= 1) { const float y = __shfl_up(inc, o); if (F.lane >= o) inc += y; }
        float run = inc - tot;
        float* dst = Ft + (size_t)sq * SEQ + F.lane * 128;
        for (int i = 0; i < 128; ++i) { run += src[(size_t)i * NH]; dst[i] = run; }
    }
}
__device__ __forceinline__ void conv_act_phase(Frame& F, const bf16* U, const float* cw, const float* cb, bf16* ACT) {
    constexpr int CPR = DFF / 8;
    for (int it = F.vcu * 512 + F.tid; it < M * CPR; it += F.G * 512) {
        const int row = it / CPR, col = (it % CPR) * 8, t = row & (SEQ - 1);
        float y[2][8];
#pragma unroll
        for (int hv = 0; hv < 2; ++hv) { const int cc = col + hv * DFF; const bf16* up = U + (size_t)row * NUP + cc;
            const v4u u2 = *(const GAS v4u*)up; v4u u1 = {0u, 0u, 0u, 0u}, u0 = u1;
            if (t >= 1) u1 = *(const GAS v4u*)(up - NUP); if (t >= 2) u0 = *(const GAS v4u*)(up - 2 * NUP);
            const unsigned a2[4] = {u2.x, u2.y, u2.z, u2.w}, a1[4] = {u1.x, u1.y, u1.z, u1.w}, a0[4] = {u0.x, u0.y, u0.z, u0.w};
#pragma unroll
            for (int e = 0; e < 8; ++e) { const float x2 = (e & 1) ? bf_hi(a2[e >> 1]) : bf_lo(a2[e >> 1]), x1 = (e & 1) ? bf_hi(a1[e >> 1]) : bf_lo(a1[e >> 1]), x0 = (e & 1) ? bf_hi(a0[e >> 1]) : bf_lo(a0[e >> 1]);
                y[hv][e] = x0 * cw[cc + e] + x1 * cw[NUP + cc + e] + x2 * cw[2 * NUP + cc + e] + cb[cc + e]; } }
        float a[8];
#pragma unroll
        for (int e = 0; e < 8; ++e) a[e] = y[0][e] / (1.f + __expf(-y[0][e])) * y[1][e];
        v4u o; o.x = pk2(a[0], a[1]); o.y = pk2(a[2], a[3]); o.z = pk2(a[4], a[5]); o.w = pk2(a[6], a[7]);
        *(GAS v4u*)(ACT + (size_t)row * DFF + col) = o;
    }
}
template <int MODE, int DK, int DV>
__device__ __forceinline__ void naive_mixer(Frame& F, const bf16* Y, int ldy, int qoff, int koff, int voff, int ooff, int NH, int GQ, const float* Ft, const float* GI, const float* sinks, bf16* AO) {
    constexpr int QP = DK + 8, DVT = DV / 8, NQT = SEQ / 64;
    LAS bf16* Qs = (LAS bf16*)(F.lds);
    LAS bf16* Ks = Qs + 64 * QP;
    LAS bf16* Vs = Ks + 32 * QP;
    LAS float* Ps = (LAS float*)(Vs + 32 * DV);
    const int tid = F.tid, qi = tid >> 3, j8 = tid & 7;
    const float NEGINF = -__builtin_inff();
    for (int u = F.vcu; u < BATCH * NH * NQT; u += F.G) {
        const int qt = (NQT - 1) - (u % NQT), bh = u / NQT, h = bh % NH, b = bh / NH, hk = h / GQ;
        const int q0 = qt * 64; const size_t rowbase = (size_t)b * SEQ;
        __syncthreads();
        for (int c = tid; c < 64 * DK / 8; c += 512) { const int r = c / (DK / 8), cc = c % (DK / 8); *(LAS v4u*)(Qs + r * QP + cc * 8) = *(const GAS v4u*)(Y + (rowbase + q0 + r) * ldy + qoff + h * DK + cc * 8); }
        float o[DVT];
#pragma unroll
        for (int e = 0; e < DVT; ++e) o[e] = 0.f;
        const int t = q0 + qi;
        float m = (MODE == 0) ? sinks[h] * LOG2E : NEGINF, l = (MODE == 0) ? 1.f : 0.f, ft_t = 0.f;
        const float* Fh = Ft + (size_t)(b * NH + h) * SEQ;
        if (MODE >= 1) ft_t = Fh[t];
        const int kt_hi = (q0 + 63) / 32; int kt_lo = 0; if (MODE == 0) kt_lo = (q0 >= 127 ? q0 - 127 : 0) / 32;
        for (int kt = kt_lo; kt <= kt_hi; ++kt) {
            __syncthreads();
            for (int c = tid; c < 32 * DK / 8; c += 512) { const int r = c / (DK / 8), cc = c % (DK / 8); *(LAS v4u*)(Ks + r * QP + cc * 8) = *(const GAS v4u*)(Y + (rowbase + kt * 32 + r) * ldy + koff + hk * DK + cc * 8); }
            for (int c = tid; c < 32 * DV / 8; c += 512) { const int r = c / (DV / 8), cc = c % (DV / 8); *(LAS v4u*)(Vs + r * DV + cc * 8) = *(const GAS v4u*)(Y + (rowbase + kt * 32 + r) * ldy + voff + hk * DV + cc * 8); }
            __syncthreads();
#pragma unroll
            for (int c4 = 0; c4 < 4; ++c4) {
                const int kk = j8 + 8 * c4, s = kt * 32 + kk;
                float dot = 0.f;
#pragma unroll 4
                for (int d = 0; d < DK; d += 8) dot += dot8(*(LAS v4u*)(Qs + qi * QP + d), *(LAS v4u*)(Ks + kk * QP + d));
                float val;
                if (MODE == 0) val = (s <= t && t - s < 128) ? dot * (0.125f * LOG2E) : NEGINF;
                else if (MODE == 1) val = (s <= t) ? dot + (ft_t - Fh[s]) * LOG2E : NEGINF;
                else val = (s <= t) ? __expf(ft_t - Fh[s] + GI[(rowbase + s) * 4 + h]) * dot : 0.f;
                Ps[qi * 33 + kk] = val;
            }
            __syncthreads();
            if (MODE < 2) {
                float tm = NEGINF;
#pragma unroll 8
                for (int kk = 0; kk < 32; ++kk) tm = fmaxf(tm, Ps[qi * 33 + kk]);
                const float mnew = fmaxf(m, tm);
                if (mnew > NEGINF) {
                    const float sc = exp2f(m - mnew); l *= sc;
#pragma unroll
                    for (int e = 0; e < DVT; ++e) o[e] *= sc;
#pragma unroll 1
                    for (int kk = 0; kk < 32; ++kk) { const float p = exp2f(Ps[qi * 33 + kk] - mnew); l += p;
#pragma unroll
                        for (int e8 = 0; e8 < DVT; e8 += 8) { const v4u vv = *(LAS v4u*)(Vs + kk * DV + j8 * DVT + e8);
                            o[e8 + 0] += p * bf_lo(vv.x); o[e8 + 1] += p * bf_hi(vv.x); o[e8 + 2] += p * bf_lo(vv.y); o[e8 + 3] += p * bf_hi(vv.y);
                            o[e8 + 4] += p * bf_lo(vv.z); o[e8 + 5] += p * bf_hi(vv.z); o[e8 + 6] += p * bf_lo(vv.w); o[e8 + 7] += p * bf_hi(vv.w); } }
                    m = mnew;
                }
            } else {
#pragma unroll 1
                for (int kk = 0; kk < 32; ++kk) { const float p = Ps[qi * 33 + kk]; l += p;
#pragma unroll
                    for (int e8 = 0; e8 < DVT; e8 += 8) { const v4u vv = *(LAS v4u*)(Vs + kk * DV + j8 * DVT + e8);
                        o[e8 + 0] += p * bf_lo(vv.x); o[e8 + 1] += p * bf_hi(vv.x); o[e8 + 2] += p * bf_lo(vv.y); o[e8 + 3] += p * bf_hi(vv.y);
                        o[e8 + 4] += p * bf_lo(vv.z); o[e8 + 5] += p * bf_hi(vv.z); o[e8 + 6] += p * bf_lo(vv.w); o[e8 + 7] += p * bf_hi(vv.w); } }
            }
        }
        const float inv = (MODE < 2) ? 1.f / l : 1.f / fmaxf(fabsf(l), 1.f);
        bf16* op = AO + (rowbase + t) * DM + h * DV + j8 * DVT;
#pragma unroll
        for (int e8 = 0; e8 < DVT; e8 += 8) {
            float r[8];
#pragma unroll
            for (int e = 0; e < 8; ++e) r[e] = o[e8 + e] * inv;
            if (MODE == 2) { const v4u og = *(const GAS v4u*)(Y + (rowbase + t) * ldy + ooff + h * DV + j8 * DVT + e8); const unsigned ow[4] = {og.x, og.y, og.z, og.w};
#pragma unroll
                for (int e = 0; e < 8; ++e) { const float ov = (e & 1) ? bf_hi(ow[e >> 1]) : bf_lo(ow[e >> 1]); r[e] *= 1.f / (1.f + __expf(-ov)); } }
            v4u w; w.x = pk2(r[0], r[1]); w.y = pk2(r[2], r[3]); w.z = pk2(r[4], r[5]); w.w = pk2(r[6], r[7]);
            *(GAS v4u*)(op + e8) = w;
        }
    }
}
constexpr int PH_FINAL = 1 + 10 * NL, PH_END = PH_FINAL + 1;
struct Args { const void* in[20]; float* out; unsigned char* ws; int ph_lo, ph_hi; };
__global__ void __launch_bounds__(NWAVES * 64, 2) fwd_kernel(Args args_unused) {
    extern __shared__ __attribute__((aligned(16))) unsigned char lds[];
    typedef const __attribute__((address_space(4))) Args* cargs_t;
#define ARGS() ({ cargs_t _a = (cargs_t)__builtin_amdgcn_kernarg_segment_ptr(); asm volatile("" : "+s"(_a)); _a; })
#define INF32(i) ((const float*)ap->in[i])
#define MKFRAME() Frame F; { int t_ = threadIdx.x; asm volatile("" : "+v"(t_)); F.lds = (LAS unsigned char*)lds; F.MISC = (volatile LAS unsigned*)(F.lds + MISC_OFF); F.tid = t_; F.lane = t_ & 63; F.wave = __builtin_amdgcn_readfirstlane(t_ >> 6); \
        F.G = gridDim.x; int bx_ = blockIdx.x; asm volatile("" : "+s"(bx_)); F.bx = bx_; F.vcu = (F.G % 8 == 0) ? (bx_ % 8) * (F.G / 8) + bx_ / 8 : bx_; }
    int lo, hi;
    { cargs_t ap = ARGS(); lo = ap->ph_lo; hi = ap->ph_hi;
      for (int u = threadIdx.x; u < (LDS_BYTES - LDSCTL_OFF) / 4; u += NWAVES * 64) ((LAS unsigned*)((LAS unsigned char*)lds + LDSCTL_OFF))[u] = 0u;
      __syncthreads();
      if (hi - lo > 1) (void)xcd_barrier_post((unsigned*)(ap->ws + WS_CTL) + CW_BAR, (volatile LAS unsigned*)((LAS unsigned char*)lds + MISC_OFF) + 8); }
#ifndef PHMASK
#define PHMASK 0xffff
#endif
#define ON(n) (((PHMASK) >> (n)) & 1)
#define IN(k) (lo <= (k) && (k) < hi)
#define SEAM(k) do { if (IN((k) + 1)) { cargs_t ap_ = ARGS(); XcdBarrier b_; b_.bar = (unsigned*)(ap_->ws + WS_CTL) + CW_BAR; b_.x = xb_xcc_id(); b_.st = (volatile LAS unsigned*)((LAS unsigned char*)lds + MISC_OFF) + 8; xcd_barrier(b_); } } while (0)

    if (ON(0) && IN(0)) { MKFRAME(); cargs_t ap = ARGS(); Ptrs P;
        P.x = INF32(0); P.c = INF32(1); P.pos = (const int*)ap->in[2]; P.mod_w = INF32(3); P.mod_b = INF32(4);
        P.norm_g = INF32(5); P.final_g = INF32(6); P.a_w_in = INF32(7); P.a_sinks = INF32(8); P.a_w_out = INF32(9);
        P.b_w_in = INF32(10); P.b_f_bias = INF32(11); P.b_w_out = INF32(12); P.c_w_in = INF32(13); P.c_gate_bias = INF32(14);
        P.c_w_out = INF32(15); P.w_up = INF32(16); P.conv_w = INF32(17); P.conv_b = INF32(18); P.w_dn = INF32(19);
        P.out = ap->out; P.ws = ap->ws;
        p0_prologue(F, P); SEAM(0); }

    for (int l = 0; l < NL; ++l) {
        const int kind = l % 3, j = l / 3, pb = 1 + 10 * l;
#define XIN() ((l == 0) ? INF32(0) : (const float*)ap->out)
#define MODP() ((const float*)(ws + WS_MODV) + (size_t)l * 2 * MODN)
        if (ON(1) && IN(pb + 0)) { MKFRAME(); cargs_t ap = ARGS(); unsigned char* ws = ap->ws; norm_phase(F, XIN(), INF32(5) + (size_t)(l * 2 + 0) * DM, MODP(), 0, (bf16*)(ws + WS_HN)); SEAM(pb + 0); }
        if (ON(2) && IN(pb + 1)) { MKFRAME(); cargs_t ap = ARGS(); unsigned char* ws = ap->ws; const bf16* HN = (const bf16*)(ws + WS_HN); bf16* Y = (bf16*)(ws + WS_Y);
            if (kind == 0) { pg8::Gemm g{HN, (const bf16*)(ws + WS_WAIN) + (size_t)j * A_IN * DM, M, A_IN, DM}; pg8::StaticOrder S; S.init(M, A_IN, F.G, F.bx);
                pg8::EpiIn<0> E{Y, A_IN, (const float*)(ws + WS_RC), (const float*)(ws + WS_RS), nullptr, nullptr, nullptr};
                pg8::gemm_phase<pg8::EpiIn<0>, pg8::StaticOrder, true, true>(F.lds + RING_OFF, g, S, E); }
            else if (kind == 1) { pg8::Gemm g{HN, (const bf16*)(ws + WS_WBIN), M, BC_PAD, DM}; pg8::StaticOrder S; S.init(M, BC_PAD, F.G, F.bx);
                pg8::EpiIn<1> E{Y, YLD, nullptr, nullptr, (float*)(ws + WS_LF), nullptr, INF32(11) + (size_t)j * 32};
                pg8::gemm_phase<pg8::EpiIn<1>, pg8::StaticOrder, true, true>(F.lds + RING_OFF, g, S, E); }
            else { pg8::Gemm g{HN, (const bf16*)(ws + WS_WCIN), M, BC_PAD, DM}; pg8::StaticOrder S; S.init(M, BC_PAD, F.G, F.bx);
                pg8::EpiIn<2> E{Y, YLD, nullptr, nullptr, (float*)(ws + WS_GI), (float*)(ws + WS_LFC), INF32(14) + (size_t)j * 8};
                pg8::gemm_phase<pg8::EpiIn<2>, pg8::StaticOrder, true, true>(F.lds + RING_OFF, g, S, E); }
            SEAM(pb + 1);
        }
        if (ON(3) && IN(pb + 2)) { MKFRAME(); cargs_t ap = ARGS(); unsigned char* ws = ap->ws;
            if (kind == 1) scan_phase(F, (const float*)(ws + WS_LF), 32, (float*)(ws + WS_FT));
            else if (kind == 2) scan_phase(F, (const float*)(ws + WS_LFC), 4, (float*)(ws + WS_FTC));
            if (kind != 0) SEAM(pb + 2);
        }
        if (ON(4) && IN(pb + 3)) { MKFRAME(); cargs_t ap = ARGS(); unsigned char* ws = ap->ws; const bf16* Y = (const bf16*)(ws + WS_Y); bf16* AO = (bf16*)(ws + WS_AO);
            if (kind == 0) naive_mixer<0, 64, 64>(F, Y, A_IN, 0, 2048, 2304, 0, 32, 8, nullptr, nullptr, INF32(8) + (size_t)j * 32, AO);
            else if (kind == 1) naive_mixer<1, 64, 64>(F, Y, YLD, 0, 2048, 4096, 0, 32, 1, (const float*)(ws + WS_FT), nullptr, nullptr, AO);
            else naive_mixer<2, 256, 512>(F, Y, YLD, 0, 1024, 2048, 4096, 4, 1, (const float*)(ws + WS_FTC), (const float*)(ws + WS_GI), nullptr, AO);
            SEAM(pb + 3);
        }
        if (ON(5) && IN(pb + 4)) { MKFRAME(); cargs_t ap = ARGS(); unsigned char* ws = ap->ws;
            pg8::Gemm g{(const bf16*)(ws + WS_AO), (const bf16*)(ws + WS_WOUT) + (size_t)l * DM * DM, M, DM, DM}; pg8::StaticOrder S; S.init(M, DM, F.G, F.bx);
            pg8::EpiRes E{XIN(), (float*)(ws + WS_X1), MODP() + 2 * DM, MODN};
            pg8::gemm_phase<pg8::EpiRes, pg8::StaticOrder, true, true>(F.lds + RING_OFF, g, S, E);
            SEAM(pb + 4);
        }
        if (ON(6) && IN(pb + 5)) { MKFRAME(); cargs_t ap = ARGS(); unsigned char* ws = ap->ws; norm_phase(F, (const float*)(ws + WS_X1), INF32(5) + (size_t)(l * 2 + 1) * DM, MODP(), 1, (bf16*)(ws + WS_HN)); SEAM(pb + 5); }
        if (ON(7) && IN(pb + 6)) { MKFRAME(); cargs_t ap = ARGS(); unsigned char* ws = ap->ws;
            pg8::Gemm g{(const bf16*)(ws + WS_HN), (const bf16*)(ws + WS_WUP) + (size_t)l * NUP * DM, M, NUP, DM}; pg8::StaticOrder S; S.init(M, NUP, F.G, F.bx);
            pg8::EpiPlain E{(bf16*)(ws + WS_U), NUP};
            pg8::gemm_phase<pg8::EpiPlain, pg8::StaticOrder, true, true>(F.lds + RING_OFF, g, S, E);
            SEAM(pb + 6);
        }
        if (ON(8) && IN(pb + 7)) { MKFRAME(); cargs_t ap = ARGS(); unsigned char* ws = ap->ws; conv_act_phase(F, (const bf16*)(ws + WS_U), INF32(17) + (size_t)l * 3 * NUP, INF32(18) + (size_t)l * NUP, (bf16*)(ws + WS_ACT)); SEAM(pb + 7); }
        if (ON(9) && IN(pb + 8)) { MKFRAME(); cargs_t ap = ARGS(); unsigned char* ws = ap->ws;
            pg8::Gemm g{(const bf16*)(ws + WS_ACT), (const bf16*)(ws + WS_WDN) + (size_t)l * DM * DFF, M, DM, DFF}; pg8::StaticOrder S; S.init(M, DM, F.G, F.bx);
            pg8::EpiRes E{(const float*)(ws + WS_X1), ap->out, MODP() + 5 * DM, MODN};
            pg8::gemm_phase<pg8::EpiRes, pg8::StaticOrder, true, true>(F.lds + RING_OFF, g, S, E);
            SEAM(pb + 8);
        }
    }
    if (ON(10) && IN(PH_FINAL)) { MKFRAME(); cargs_t ap = ARGS(); final_norm_phase(F, ap->out, INF32(6), ap->out); }
#undef IN
#undef SEAM
}

#ifndef MK_ONE_LAUNCH
#define MK_ONE_LAUNCH 0
#endif
extern "C" void kernel_launch(void* const* d_in, const int* in_sizes, int n_in, void* d_out, int out_size, void* d_ws, size_t ws_size, hipStream_t stream) {
    static int grid = 0;
    if (grid == 0) {
        if (n_in != 20 || in_sizes[0] != M * DM || out_size != M * DM || ws_size < WS_END) { fprintf(stderr, "kernel_launch: unexpected shapes (n_in %d, in0 %d, out %d, ws %zu < %zu); nothing launched\n", n_in, n_in > 0 ? in_sizes[0] : -1, out_size, ws_size, (size_t)WS_END); grid = -1; return; }
        int dev = 0, cus = 0, per_cu = 0;
        if (hipGetDevice(&dev) != hipSuccess || hipDeviceGetAttribute(&cus, hipDeviceAttributeMultiprocessorCount, dev) != hipSuccess) { grid = -1; return; }
        if (hipFuncSetAttribute((const void*)fwd_kernel, hipFuncAttributeMaxDynamicSharedMemorySize, LDS_BYTES) != hipSuccess) { fprintf(stderr, "kernel_launch: hipFuncSetAttribute failed\n"); grid = -1; return; }
        if (hipOccupancyMaxActiveBlocksPerMultiprocessor(&per_cu, (const void*)fwd_kernel, NWAVES * 64, LDS_BYTES) != hipSuccess || per_cu < 1) fprintf(stderr, "kernel_launch: occupancy query reports %d\n", per_cu);
        (void)hipGetLastError();
        grid = cus;
    }
    if (grid < 0) return;
    (void)hipMemsetAsync((char*)d_ws + WS_CTL, 0, CTL_ZERO_BYTES, stream);
    Args a{};
    for (int i = 0; i < 20; ++i) a.in[i] = d_in[i];
    a.out = (float*)d_out; a.ws = (unsigned char*)d_ws;
#if MK_ONE_LAUNCH
    a.ph_lo = 0; a.ph_hi = PH_END;
    hipLaunchKernelGGL(fwd_kernel, dim3(grid), dim3(NWAVES * 64), LDS_BYTES, stream, a);
#else
    for (int ph = 0; ph < PH_END; ++ph) {
        if (ph >= 1 && ph < PH_FINAL) { const int l = (ph - 1) / 10, k = (ph - 1) % 10; if (k == 9 || (k == 2 && (l % 3) == 0)) continue; }
        a.ph_lo = ph; a.ph_hi = ph + 1;
        hipLaunchKernelGGL(fwd_kernel, dim3(grid), dim3(NWAVES * 64), LDS_BYTES, stream, a);
    }
#endif
}
```

```cpp
#include <hip/hip_runtime.h>
#include <cstdio>
#include <cstdint>
__device__ __forceinline__ int lane_id_fresh() { unsigned z = 0u; asm volatile("" : "+v"(z));
    return (int)__builtin_amdgcn_mbcnt_hi(~0u, __builtin_amdgcn_mbcnt_lo(~0u, z)); }
constexpr int NWAVES = 8;
constexpr int BATCH = 2, SEQ = 8192, DM = 2048, M = BATCH * SEQ, DFF = 5632, NUP = 2 * DFF, NL = 4;
constexpr int A_IN = 2560, B_IN = 6176, C_IN = 6152, BC_PAD = 6400, YLD = 6144, MODN = 6 * DM;
constexpr float LOG2E = 1.4426950408889634f;
constexpr size_t MiB = 1u << 20;
constexpr size_t WS_CTL = 0, CTL_ZERO_BYTES = 4 * MiB;
constexpr size_t WS_SS = 64 * 1024;
constexpr size_t WS_BIAS = 1280 * 1024;
constexpr float SS_SCALE = 16777216.f, SS_INV = 1.f / 16777216.f, BIAS_SCALE = 68719476736.f, BIAS_INV = 1.f / 68719476736.f;
constexpr int BIAS_A = 0, BIAS_B = 10240, BIAS_C = 23040, BIAS_UP = 35840, BIAS_END = 125952;
static_assert(WS_BIAS + (size_t)BIAS_END * 8 <= CTL_ZERO_BYTES && WS_SS + 9 * 16384 * 8 <= WS_BIAS, "zeroed region");
constexpr size_t WS_MODV = 4 * MiB, WS_RC = 5 * MiB, WS_RS = 7 * MiB, WS_LF = 9 * MiB, WS_FT = 11 * MiB, WS_GI = 13 * MiB, WS_LFC = 14 * MiB, WS_FTC = 15 * MiB;
constexpr size_t WS_WAIN = 16 * MiB, WS_WBIN = 56 * MiB, WS_WCIN = 106 * MiB, WS_WOUT = 156 * MiB, WS_WUP = 188 * MiB, WS_WDN = 540 * MiB;
constexpr size_t WS_X1 = 628 * MiB, WS_HN = 756 * MiB, WS_Y = 820 * MiB, WS_AO = 1012 * MiB, WS_ACT = 1076 * MiB, WS_U = 1252 * MiB, WS_END = 1412 * MiB;
constexpr size_t WS_HU = 1400 * MiB;
constexpr size_t WS_CST = WS_ACT;
constexpr size_t WS_QF = WS_U, WS_KF = WS_U + 32 * MiB, WS_VF = WS_U + 64 * MiB, WS_AF = WS_U + 128 * MiB, WS_EG = WS_U + 136 * MiB;
constexpr int CW_TMO = 0, CW_BAR = 4096, CW_QUEUE = 2048, CW_BGQ = 2048 + 64;
constexpr size_t WS_QK2 = 48 * 1024;
constexpr int XCH_OFF = 131072;
constexpr int RING_OFF = 0, RING_BYTES = 155648, LDSCTL_OFF = RING_BYTES, MISC_OFF = LDSCTL_OFF + 320, LDS_BYTES = 163840;
struct Args { const void* in[20]; float* out; unsigned char* ws; int ph_lo, ph_hi; };
namespace pg8 {
#define PG8_LAS __attribute__((address_space(3)))
typedef unsigned short bf16_t;
typedef short bf16x8 __attribute__((ext_vector_type(8)));
typedef float f32x4 __attribute__((ext_vector_type(4)));
typedef unsigned u32x4 __attribute__((ext_vector_type(4)));
constexpr int BM = 256, BK = 64, HALF = 128, HTB = HALF * BK * 2  , STAGE_BYTES = 8 * HTB, NXCD = 8, WGM = 8;

__host__ __device__ __forceinline__ int lds_byte(int r, int c) { const int st = (r >> 4) * 2 + (c >> 5), rr = r & 15, cc = c & 31, ob = rr * 64 + cc * 2; return st * 1024 + (ob ^ (((ob >> 9) & 1) << 5)); }
__host__ __device__ __forceinline__ void stage_rc(int b, int& R, int& C) { const int st = b / 1024, sb = b % 1024, swz = sb ^ (((sb >> 9) & 1) << 5); R = (st >> 1) * 16 + swz / 64; C = (st & 1) * 32 + (swz % 64) / 2; }
__host__ __device__ __forceinline__ int perm32(int rho) { const int n = rho >> 4, i = rho & 15; return 8 * (i >> 2) + 4 * n + (i & 3); }

struct Unit { int pm, pn; };
struct Gemm { const bf16_t* A; const bf16_t* Bt; int M, N, K; size_t bstride; };

struct StaticOrder {
    int nM, nN, nwg, G, c;
    __host__ __device__ void init(int M, int N, int G_, int c_) { nM = M / BM; nN = N / BM; nwg = nM * nN; G = G_; c = c_; }
    __host__ __device__ bool next(int i, Unit& u) const {
        const long L = (long)i * G + c; if (L >= nwg) return false;
        int wgid = (int)L; { const int q = nwg / NXCD, r = nwg % NXCD, xcd = wgid % NXCD, off = wgid / NXCD; wgid = (xcd < r ? xcd * (q + 1) : r * (q + 1) + (xcd - r) * q) + off; }
        const int nig = WGM * nN, gid = wgid / nig, fm = gid * WGM, gsz = (nM - fm) < WGM ? (nM - fm) : WGM;
        u.pm = fm + ((wgid % nig) % gsz); u.pn = (wgid % nig) / gsz; return true;
    }
    __device__ __forceinline__ void a_ready(const Unit&) const {}
    __device__ __forceinline__ void done(const Unit&) const {}
};

__device__ __forceinline__ unsigned cvt_pk_bf16(float lo, float hi) { unsigned r; asm volatile("v_cvt_pk_bf16_f32 %0, %1, %2" : "=v"(r) : "v"(lo), "v"(hi)); return r; }
typedef float f32x2 __attribute__((ext_vector_type(2)));
template <class Epi, class Sched, bool ALIGN_EPI = false, bool SP2 = false>
__device__ __forceinline__ void gemm_phase(PG8_LAS unsigned char* lds, const Gemm g, const Sched& S, const Epi& E, const int wv  ) {
    if constexpr (Epi::SKEW > 0) { if ((blockIdx.x >> 3) & 1) {
#pragma unroll 1
        for (int i_ = 0; i_ < Epi::SKEW; ++i_) __builtin_amdgcn_s_sleep(16); } }
    int tid_ = wv * 64 + lane_id_fresh();
    const int tid = tid_, wid = __builtin_amdgcn_readfirstlane(tid >> 6), lane = tid & 63, wr = wid >> 2, wc = wid & 3, fr = lane & 15, fq = lane >> 4;
    const int K = g.K, nt = K / BK;
    unsigned voffA[2], voffB[2];
#pragma unroll
    for (int i = 0; i < 2; ++i) { int R, C; stage_rc(tid * 16 + i * 8192, R, C); const int Rb = Epi::PERM ? ((R & ~31) + perm32(R & 31)) : R;
        voffA[i] = (unsigned)(R * K + C) * 2u; voffB[i] = (unsigned)(Rb * K + C) * 2u; }
    voffA[1] = voffA[0] + 128u * (unsigned)K; voffB[1] = voffB[0] + 128u * (unsigned)K;
    const size_t kstep = (size_t)(BK * 2);
    const size_t hstep = (size_t)HALF * K * 2;
    const size_t tstep = 2 * hstep;
    const unsigned ldsw = (unsigned)wid * 1024u;
    const int aoff = lds_byte(wr * 64 + fr, fq * 8), boff = lds_byte(wc * 32 + fr, fq * 8);
#define PG8_SA(b, h) (((b) * 2 + (h)) * HTB)
#define PG8_SB(b, h) ((4 + (b) * 2 + (h)) * HTB)
#define PG8_STAGE(bufoff, gbase, voff) do { _Pragma("unroll") for (int _i = 0; _i < 2; ++_i) \
        __builtin_amdgcn_global_load_lds((const unsigned*)((const char*)(gbase) + (voff)[_i]), (PG8_LAS unsigned*)(lds + (bufoff) + ldsw + _i * 8192), 16, 0, 0); } while (0)
#define PG8_LDA(dst, b, h) do { _Pragma("unroll") for (int m = 0; m < 4; ++m) _Pragma("unroll") for (int k = 0; k < 2; ++k) dst[m][k] = *(const PG8_LAS bf16x8*)(lds + PG8_SA(b, h) + aoff + m * 2048 + k * 1024); } while (0)
#define PG8_LDB(dst, b, h) do { _Pragma("unroll") for (int n = 0; n < 2; ++n) _Pragma("unroll") for (int k = 0; k < 2; ++k) dst[n][k] = *(const PG8_LAS bf16x8*)(lds + PG8_SB(b, h) + boff + n * 2048 + k * 1024); } while (0)
#define PG8_MMA(ai, bj, At, Bt) do { __builtin_amdgcn_s_setprio(1); _Pragma("unroll") for (int m = 0; m < 4; ++m) _Pragma("unroll") for (int n = 0; n < 2; ++n) _Pragma("unroll") for (int k = 0; k < 2; ++k) \
        acc[ai][bj][m][n] = __builtin_amdgcn_mfma_f32_16x16x32_bf16(Bt[n][k], At[m][k], acc[ai][bj][m][n], 0, 0, 0); __builtin_amdgcn_s_setprio(0); } while (0)
#define PG8_WAIT_V(n) asm volatile("s_waitcnt vmcnt(" #n ")" ::: "memory")
#define PG8_WAIT_L(n) asm volatile("s_waitcnt lgkmcnt(" #n ")" ::: "memory")
#define PG8_BAR __builtin_amdgcn_s_barrier()
#define PG8_SCHED __builtin_amdgcn_sched_barrier(0)
    Unit cur, nxt; int ui = 0;
    if (!S.next(0, cur)) return;
    f32x4 acc[2][2][4][2];
#pragma unroll
    for (int a = 0; a < 2; ++a)
#pragma unroll
        for (int b = 0; b < 2; ++b)
#pragma unroll
            for (int m = 0; m < 4; ++m)
#pragma unroll
                for (int n = 0; n < 2; ++n) acc[a][b][m][n] = (f32x4){0.f, 0.f, 0.f, 0.f};
    bf16x8 At[4][2], B0[2][2], B1[2][2];
    const char* cA = (const char*)g.A + (size_t)cur.pm * tstep; const char* cB = (const char*)g.Bt + (size_t)cur.pn * tstep + (cur.pm >= 32 ? g.bstride * 2 : 0);
    S.a_ready(cur);
    if constexpr (SP2) {
        PG8_STAGE(PG8_SB(0, 0), cB, voffB); PG8_STAGE(PG8_SB(0, 1), cB + hstep, voffB); PG8_STAGE(PG8_SA(0, 0), cA, voffA); PG8_STAGE(PG8_SA(0, 1), cA + hstep, voffA);
        if (wr == 1) PG8_BAR;
        PG8_WAIT_V(2); PG8_BAR;
        PG8_STAGE(PG8_SB(1, 0), cB + kstep, voffB); PG8_STAGE(PG8_SA(1, 0), cA + kstep, voffA); PG8_STAGE(PG8_SB(1, 1), cB + hstep + kstep, voffB);
        PG8_WAIT_V(6); PG8_BAR;
    } else {
        PG8_STAGE(PG8_SB(0, 0), cB, voffB); PG8_STAGE(PG8_SA(0, 0), cA, voffA); PG8_STAGE(PG8_SB(0, 1), cB + hstep, voffB); PG8_STAGE(PG8_SA(0, 1), cA + hstep, voffA);
        if (wr == 1) PG8_BAR;
        PG8_WAIT_V(4); PG8_BAR;
        PG8_STAGE(PG8_SB(1, 0), cB + kstep, voffB); PG8_STAGE(PG8_SA(1, 0), cA + kstep, voffA); PG8_STAGE(PG8_SB(1, 1), cB + hstep + kstep, voffB);
        PG8_WAIT_V(6); PG8_BAR;
    }
    for (;;) {
        const bool has_next = S.next(ui + 1, nxt);
        if constexpr (Epi::HAS_PF) E.prefetch(cur, ui & 1, wid, lane_id_fresh()  );
        const char* nA = has_next ? (const char*)g.A + (size_t)nxt.pm * tstep : cA; const char* nB = has_next ? (const char*)g.Bt + (size_t)nxt.pn * tstep + (nxt.pm >= 32 ? g.bstride * 2 : 0) : cB;
        for (int t = 0; t < nt; t += 2) {
            const bool last = (t == nt - 2);
            const char* a1 = cA + (size_t)(t + 1) * kstep;
            const char* a2 = last ? nA : cA + (size_t)(t + 2) * kstep; const char* b2 = last ? nB : cB + (size_t)(t + 2) * kstep;
            const char* a3 = a2 + kstep; const char* b3 = b2 + kstep;
            if (last && has_next) S.a_ready(nxt);
            if constexpr (SP2) {
            PG8_LDB(B0, 0, 0); PG8_LDB(B1, 0, 1); PG8_SCHED; PG8_LDA(At, 0, 0); PG8_STAGE(PG8_SA(1, 1), a1 + hstep, voffA);
            PG8_WAIT_V(8); PG8_WAIT_L(0); PG8_BAR; PG8_MMA(0, 0, At, B0); PG8_MMA(0, 1, At, B1); PG8_BAR; PG8_SCHED;
            PG8_LDA(At, 0, 1); PG8_STAGE(PG8_SB(0, 0), b2, voffB); PG8_STAGE(PG8_SB(0, 1), b2 + hstep, voffB); PG8_STAGE(PG8_SA(0, 0), a2, voffA);
            PG8_WAIT_V(8); PG8_WAIT_L(0); PG8_BAR; PG8_MMA(1, 0, At, B0); PG8_MMA(1, 1, At, B1); PG8_BAR; PG8_SCHED;
            PG8_LDB(B0, 1, 0); PG8_LDB(B1, 1, 1); PG8_SCHED; PG8_LDA(At, 1, 0); PG8_STAGE(PG8_SA(0, 1), a2 + hstep, voffA);
            PG8_WAIT_V(8); PG8_WAIT_L(0); PG8_BAR; PG8_MMA(0, 0, At, B0); PG8_MMA(0, 1, At, B1); PG8_BAR; PG8_SCHED;
            PG8_LDA(At, 1, 1); PG8_STAGE(PG8_SB(1, 0), b3, voffB); PG8_STAGE(PG8_SB(1, 1), b3 + hstep, voffB); PG8_STAGE(PG8_SA(1, 0), a3, voffA);
            PG8_WAIT_V(8); PG8_WAIT_L(0); PG8_BAR; PG8_MMA(1, 0, At, B0); PG8_MMA(1, 1, At, B1); PG8_BAR; PG8_SCHED;
            } else {
            PG8_LDB(B0, 0, 0); PG8_SCHED; PG8_LDA(At, 0, 0); PG8_STAGE(PG8_SA(1, 1), a1 + hstep, voffA);
            PG8_WAIT_L(8); PG8_BAR; PG8_WAIT_L(0); PG8_MMA(0, 0, At, B0); PG8_BAR; PG8_SCHED;
            PG8_LDB(B1, 0, 1); PG8_STAGE(PG8_SB(0, 0), b2, voffB);
            PG8_BAR; PG8_WAIT_L(0); PG8_MMA(0, 1, At, B1); PG8_BAR;
            PG8_LDA(At, 0, 1); PG8_STAGE(PG8_SA(0, 0), a2, voffA);
            PG8_BAR; PG8_WAIT_L(0); PG8_MMA(1, 0, At, B0); PG8_BAR; PG8_SCHED;
            PG8_STAGE(PG8_SB(0, 1), b2 + hstep, voffB);
            PG8_WAIT_V(6); PG8_BAR; PG8_MMA(1, 1, At, B1); PG8_BAR;
            PG8_LDB(B0, 1, 0); PG8_SCHED; PG8_LDA(At, 1, 0); PG8_STAGE(PG8_SA(0, 1), a2 + hstep, voffA);
            PG8_WAIT_L(8); PG8_BAR; PG8_WAIT_L(0); PG8_MMA(0, 0, At, B0); PG8_BAR; PG8_SCHED;
            PG8_LDB(B1, 1, 1); PG8_STAGE(PG8_SB(1, 0), b3, voffB);
            PG8_BAR; PG8_WAIT_L(0); PG8_MMA(0, 1, At, B1); PG8_BAR;
            PG8_LDA(At, 1, 1); PG8_STAGE(PG8_SA(1, 0), a3, voffA);
            PG8_BAR; PG8_WAIT_L(0); PG8_MMA(1, 0, At, B0); PG8_BAR; PG8_SCHED;
            PG8_STAGE(PG8_SB(1, 1), b3 + hstep, voffB);
            PG8_WAIT_V(6); PG8_BAR; PG8_MMA(1, 1, At, B1); PG8_BAR;
            }
        }
        if constexpr (ALIGN_EPI) { if (wr == 0) PG8_BAR; }
        if constexpr (!Epi::AFTER_DRAIN) { int t2_ = lane_id_fresh();
#if defined(PROBE_EPIN) && PROBE_EPIN
            if constexpr (Epi::EPI_KIND == PROBE_EPIN) { int nrep_ = 2; asm volatile("" : "+s"(nrep_));
                for (int rep_ = 0; rep_ < nrep_; ++rep_) { if constexpr (Epi::HAS_PF) E(acc, cur, wr, wc, t2_ & 15, (t2_ >> 4) & 3, (ui & 1) | (rep_ ? 2 : 0)); else { Epi E2 = E; E2.prb = rep_; E2(acc, cur, wr, wc, t2_ & 15, (t2_ >> 4) & 3); } asm volatile("" ::: "memory"); }
            } else
#endif
            { if constexpr (Epi::HAS_PF) E(acc, cur, wr, wc, t2_ & 15, (t2_ >> 4) & 3, ui & 1); else E(acc, cur, wr, wc, t2_ & 15, (t2_ >> 4) & 3); }
            S.done(cur); }
        if (!has_next) break;
#pragma unroll
        for (int a = 0; a < 2; ++a)
#pragma unroll
            for (int b = 0; b < 2; ++b)
#pragma unroll
                for (int m = 0; m < 4; ++m)
#pragma unroll
                    for (int n = 0; n < 2; ++n) acc[a][b][m][n] = (f32x4){0.f, 0.f, 0.f, 0.f};
        cur = nxt; cA = nA; cB = nB; ++ui;
        if constexpr (ALIGN_EPI) { if (wr == 1) PG8_BAR; }
    }
    PG8_WAIT_V(0);
    if constexpr (!ALIGN_EPI) { if (wr == 0) PG8_BAR; }
    PG8_BAR;
    if constexpr (Epi::AFTER_DRAIN) { E.fused(acc, cur, wr, wc, fr, fq, lds, wid, lane); S.done(cur); }
#undef PG8_SA
#undef PG8_SB
#undef PG8_STAGE
#undef PG8_LDA
#undef PG8_LDB
#undef PG8_MMA
#undef PG8_WAIT_V
#undef PG8_WAIT_L
#undef PG8_BAR
#undef PG8_SCHED
}
#ifndef SKEW_IN
#define SKEW_IN 0
#define SKEW_RES 0
#define SKEW_UP 0
#endif
typedef unsigned u32x2 __attribute__((ext_vector_type(2)));
__device__ __forceinline__ float log_sigmoid_f(float x) { return fminf(x, 0.f) - __logf(1.f + __expf(-fabsf(x))); }
__device__ __forceinline__ void st_bf16x8(bf16_t* p, f32x4 v0, f32x4 v1) { u32x4 w; w.x = cvt_pk_bf16(v0[0], v0[1]); w.y = cvt_pk_bf16(v0[2], v0[3]); w.z = cvt_pk_bf16(v1[0], v1[1]); w.w = cvt_pk_bf16(v1[2], v1[3]); *(u32x4*)p = w; }

typedef const __attribute__((address_space(4))) Args* kargs_t;
__device__ __forceinline__ kargs_t kargs() { kargs_t a = (kargs_t)__builtin_amdgcn_kernarg_segment_ptr(); asm volatile("" : "+s"(a)); return a; }
typedef unsigned u32x4n __attribute__((ext_vector_type(4)));
__device__ __forceinline__ float fx2f(unsigned lo, unsigned hi) { return (float)(int)hi * 4294967296.f + (float)lo; }
__device__ __forceinline__ void apply_norm(f32x4 (&acc)[2][2][4][2], const long long* ss, const long long* bp, int row0) {
    f32x4 bv[2][2];
#pragma unroll
    for (int bj = 0; bj < 2; ++bj)
#pragma unroll
        for (int n = 0; n < 2; ++n) { const u32x4n a = *(const u32x4n*)(bp + bj * HALF + 4 * n), b = *(const u32x4n*)(bp + bj * HALF + 4 * n + 2);
            bv[bj][n] = (f32x4){fx2f(a[0], a[1]) * BIAS_INV, fx2f(a[2], a[3]) * BIAS_INV, fx2f(b[0], b[1]) * BIAS_INV, fx2f(b[2], b[3]) * BIAS_INV}; }
#pragma unroll
    for (int ai = 0; ai < 2; ++ai)
#pragma unroll
        for (int m = 0; m < 4; ++m) { typedef unsigned u32x2n __attribute__((ext_vector_type(2))); const u32x2n sv = *(const u32x2n*)(ss + row0 + ai * HALF + m * 16);
            const float rstd = __builtin_amdgcn_rsqf(fx2f(sv[0], sv[1]) * (SS_INV / 2048.f) + 1e-6f);
#pragma unroll
            for (int bj = 0; bj < 2; ++bj)
#pragma unroll
                for (int n = 0; n < 2; ++n) acc[ai][bj][m][n] = acc[ai][bj][m][n] * rstd + bv[bj][n]; }
    __builtin_amdgcn_sched_barrier(0);
}
__device__ __forceinline__ void apply_norm_lds(f32x4 (&acc)[2][2][4][2], const PG8_LAS long long* ss  , const PG8_LAS long long* bp  , int rowl) {
    f32x4 bv[2][2];
#pragma unroll
    for (int bj = 0; bj < 2; ++bj)
#pragma unroll
        for (int n = 0; n < 2; ++n) { const u32x4n a = *(const PG8_LAS u32x4n*)(bp + bj * HALF + 4 * n), b = *(const PG8_LAS u32x4n*)(bp + bj * HALF + 4 * n + 2);
            bv[bj][n] = (f32x4){fx2f(a[0], a[1]) * BIAS_INV, fx2f(a[2], a[3]) * BIAS_INV, fx2f(b[0], b[1]) * BIAS_INV, fx2f(b[2], b[3]) * BIAS_INV}; }
#pragma unroll
    for (int ai = 0; ai < 2; ++ai)
#pragma unroll
        for (int m = 0; m < 4; ++m) { typedef unsigned u32x2n __attribute__((ext_vector_type(2))); const u32x2n sv = *(const PG8_LAS u32x2n*)(ss + rowl + ai * HALF + m * 16);
            const float rstd = __builtin_amdgcn_rsqf(fx2f(sv[0], sv[1]) * (SS_INV / 2048.f) + 1e-6f);
#pragma unroll
            for (int bj = 0; bj < 2; ++bj)
#pragma unroll
                for (int n = 0; n < 2; ++n) acc[ai][bj][m][n] = acc[ai][bj][m][n] * rstd + bv[bj][n]; }
    __builtin_amdgcn_sched_barrier(0);
}
template <int KIND> struct EpiIn {
    static constexpr bool PERM = true, AFTER_DRAIN = false, TWICE = false, HAS_PF = false;
    static constexpr int EPI_KIND = 1;
    static constexpr int SKEW = SKEW_IN;
    int l, prb;
    __device__ __forceinline__ void operator()(f32x4 (&acc)[2][2][4][2], const Unit& u, int wr, int wc, int fr, int fq) const {
        asm volatile("" : "+v"(fr), "+v"(fq)); asm volatile("" : "+s"(wr), "+s"(wc));
        const kargs_t ap = kargs(); unsigned char* ws = ap->ws; const int j = l / 3;
        bf16_t* Y = (bf16_t*)(ws + WS_Y); constexpr int ldy = (KIND == 0) ? 2560 : 6144, npad = (KIND == 0) ? 2560 : 6400;
        const float* rc = (const float*)(ws + WS_RC); const float* rs = (const float*)(ws + WS_RS);
        float* G0 = (float*)(ws + (KIND == 1 ? WS_LF : WS_GI)); float* G1 = (float*)(ws + WS_LFC);
        const float* gbias = (KIND == 1) ? (const float*)ap->in[11] + j * 32 : (const float*)ap->in[14] + j * 8;
        const long long* ss = (const long long*)(ws + WS_SS) + (size_t)(2 * l) * 16384;
        const long long* bias = (const long long*)(ws + WS_BIAS) + (KIND == 0 ? BIAS_A + j * 2 * 2560 : KIND == 1 ? BIAS_B : BIAS_C);
        const int row0 = u.pm * BM + wr * 64 + fr, ct = u.pn * BM + wc * 32 + 8 * fq;
        if (!prb) apply_norm(acc, ss, bias + (u.pm >= 32 ? npad : 0) + ct, row0);
        if (KIND != 0 && u.pn == 24) {
            if (wc == 0) {
#pragma unroll
                for (int ai = 0; ai < 2; ++ai)
#pragma unroll
                    for (int m = 0; m < 4; ++m) { const int row = row0 + ai * HALF + m * 16; const f32x4 v0 = acc[ai][0][m][0], v1 = acc[ai][0][m][1];
                        if (KIND == 1) { f32x4 a, b;
#pragma unroll
                            for (int e = 0; e < 4; ++e) { a[e] = log_sigmoid_f(v0[e] + gbias[8 * fq + e]); b[e] = log_sigmoid_f(v1[e] + gbias[8 * fq + 4 + e]); }
                            *(f32x4*)(G0 + (size_t)row * 32 + 8 * fq) = a; *(f32x4*)(G0 + (size_t)row * 32 + 8 * fq + 4) = b; }
                        else if (fq == 0) { f32x4 a, b;
#pragma unroll
                            for (int e = 0; e < 4; ++e) { a[e] = v0[e] + gbias[e]; b[e] = log_sigmoid_f(v1[e] + gbias[4 + e]); }
                            *(f32x4*)(G0 + (size_t)row * 4) = a; *(f32x4*)(G1 + (size_t)row * 4) = b; } }
            }
            return;
        }
        if (KIND == 1 && u.pn < 16) {
            const float s2 = (u.pn < 8) ? (0.125f * 1.4426950408889634f) * (0.125f * 1.4426950408889634f) : 1.f;
            unsigned* qk2 = (unsigned*)(ws + WS_QK2); const int ln = fq * 16 + fr;
#pragma unroll
            for (int bj = 0; bj < 2; ++bj) { float mx = 0.f;
#pragma unroll
                for (int ai = 0; ai < 2; ++ai)
#pragma unroll
                    for (int m = 0; m < 4; ++m) { const f32x4 a = acc[ai][bj][m][0], c = acc[ai][bj][m][1];
                        float s = (a[0] * a[0] + a[1] * a[1]) + (a[2] * a[2] + a[3] * a[3]) + (c[0] * c[0] + c[1] * c[1]) + (c[2] * c[2] + c[3] * c[3]);
                        s += __int_as_float(__builtin_amdgcn_ds_bpermute((ln ^ 16) << 2, __float_as_int(s))); s += __int_as_float(__builtin_amdgcn_ds_bpermute((ln ^ 32) << 2, __float_as_int(s)));
                        mx = fmaxf(mx, s); }
#pragma unroll
                for (int o = 1; o < 16; o <<= 1) mx = fmaxf(mx, __int_as_float(__builtin_amdgcn_ds_bpermute((ln ^ o) << 2, __float_as_int(mx))));
                const int colh = (u.pn & 7) * BM + bj * HALF + wc * 32;
                if (ln == 0) atomicMax(qk2 + (((u.pm >= 32 ? 32 : 0) + (colh >> 6)) * 4 + (u.pn < 8 ? 0 : 2) + ((colh >> 5) & 1)), __float_as_uint(mx * s2 * 1.0001f)); } }
        float sc = 1.f; if (KIND <= 1 && u.pn < 8) sc = 0.125f * 1.4426950408889634f;     if (KIND == 2 && u.pn < 4) sc = 0.0625f;
        const bool rope = (KIND == 0) && (u.pn < 9); const int j4 = 4 * (4 * (wc & 1) + fq);
#pragma unroll
        for (int ai = 0; ai < 2; ++ai)
#pragma unroll
            for (int m = 0; m < 4; ++m) { const int row = row0 + ai * HALF + m * 16; bf16_t* rowp = Y + (size_t)row * ldy + ct;
                f32x4 c4 = {1.f, 1.f, 1.f, 1.f}, s4 = {0.f, 0.f, 0.f, 0.f};
                if (rope) { c4 = *(const f32x4*)(rc + (size_t)row * 32 + j4); s4 = *(const f32x4*)(rs + (size_t)row * 32 + j4); }
#pragma unroll
                for (int bj = 0; bj < 2; ++bj) { f32x4 v0 = acc[ai][bj][m][0], v1 = acc[ai][bj][m][1];
                    if (KIND == 0) { const f32x4 o0 = v0 * c4 - v1 * s4, o1 = v1 * c4 + v0 * s4; v0 = o0 * sc; v1 = o1 * sc; } else { v0 = v0 * sc; v1 = v1 * sc; }
                    st_bf16x8(rowp + bj * HALF, v0, v1); } }
    }
};
struct EpiPlain {
    static constexpr bool PERM = true, AFTER_DRAIN = false, TWICE = false, HAS_PF = false;
    static constexpr int EPI_KIND = 0;
    static constexpr int SKEW = 0;
    bf16_t* Y; int ldy;
    __device__ __forceinline__ void operator()(const f32x4 (&acc)[2][2][4][2], const Unit& u, int wr, int wc, int fr, int fq) const {
        asm volatile("" : "+v"(fr), "+v"(fq)); asm volatile("" : "+s"(wr), "+s"(wc));
        const int row0 = u.pm * BM + wr * 64 + fr, ct = u.pn * BM + wc * 32 + 8 * fq;
#pragma unroll
        for (int ai = 0; ai < 2; ++ai)
#pragma unroll
            for (int m = 0; m < 4; ++m) { bf16_t* rowp = Y + (size_t)(row0 + ai * HALF + m * 16) * ldy + ct;
#pragma unroll
                for (int bj = 0; bj < 2; ++bj) st_bf16x8(rowp + bj * HALF, acc[ai][bj][m][0], acc[ai][bj][m][1]); }
    }
};
struct EpiRes {
    static constexpr bool PERM = true, AFTER_DRAIN = false, TWICE = true, HAS_PF = false;
    static constexpr int EPI_KIND = 2;
    static constexpr int SKEW = SKEW_RES;
    int l, which, prb; PG8_LAS float* sx;
    __device__ __forceinline__ void operator()(const f32x4 (&acc)[2][2][4][2], const Unit& u, int wr, int wc, int fr, int fq) const {
        asm volatile("" : "+v"(fr), "+v"(fq)); asm volatile("" : "+s"(wr), "+s"(wc));
        const kargs_t ap = kargs(); unsigned char* ws = ap->ws;
        const bf16_t* xi = (const bf16_t*)(ws + (which ? WS_X1 : WS_HN)); bf16_t* xo = (bf16_t*)(ws + (which ? WS_HN : WS_X1));
        unsigned long long* ssq = (unsigned long long*)(ws + WS_SS) + (size_t)(2 * l + 1 + which) * 16384;
        const float* g = (const float*)(ws + WS_MODV) + (size_t)l * 2 * 12288 + (which ? 5 : 2) * 2048 + (u.pm >= 32 ? 12288 : 0);
        const int col0 = u.pn * BM + wc * 32 + 8 * fq;
        const int rb = u.pm * BM + wr * 64, pl = 16 * (fr & 3) + (fr >> 2);
        const int xi0 = rb + (which ? pl : fr), xis = which ? 4 : 16, xo0 = rb + (which ? fr : pl), xos = which ? 16 : 4;
        u32x4 bw[2][4][2];
#pragma unroll
        for (int ai = 0; ai < 2; ++ai)
#pragma unroll
            for (int m = 0; m < 4; ++m)
#pragma unroll
                for (int bj = 0; bj < 2; ++bj) bw[ai][m][bj] = *(const u32x4*)(xi + (size_t)(xi0 + ai * HALF + m * xis) * 2048 + col0 + bj * HALF);
        f32x4 gv[2][2];
#pragma unroll
        for (int bj = 0; bj < 2; ++bj)
#pragma unroll
            for (int n = 0; n < 2; ++n) gv[bj][n] = *(const f32x4*)(g + col0 + bj * HALF + 4 * n);
        __builtin_amdgcn_sched_barrier(0);
        float sv[2][4];
#pragma unroll
        for (int ai = 0; ai < 2; ++ai)
#pragma unroll
            for (int m = 0; m < 4; ++m) { const size_t off = (size_t)(xo0 + ai * HALF + m * xos) * 2048 + col0; float s = 0.f;
#pragma unroll
                for (int bj = 0; bj < 2; ++bj) { const u32x4 w = bw[ai][m][bj];
                    const f32x4 b0 = {__uint_as_float(w.x << 16), __uint_as_float(w.x & 0xffff0000u), __uint_as_float(w.y << 16), __uint_as_float(w.y & 0xffff0000u)};
                    const f32x4 b1 = {__uint_as_float(w.z << 16), __uint_as_float(w.z & 0xffff0000u), __uint_as_float(w.w << 16), __uint_as_float(w.w & 0xffff0000u)};
                    const f32x4 o0 = b0 + gv[bj][0] * acc[ai][bj][m][0], o1 = b1 + gv[bj][1] * acc[ai][bj][m][1];
                    st_bf16x8(xo + off + bj * HALF, o0, o1);
                    s += (o0[0] * o0[0] + o0[1] * o0[1]) + (o0[2] * o0[2] + o0[3] * o0[3]) + (o1[0] * o1[0] + o1[1] * o1[1]) + (o1[2] * o1[2] + o1[3] * o1[3]); }
                { const int ln = fq * 16 + fr; s += __int_as_float(__builtin_amdgcn_ds_bpermute((ln ^ 16) << 2, __float_as_int(s))); s += __int_as_float(__builtin_amdgcn_ds_bpermute((ln ^ 32) << 2, __float_as_int(s))); }
                sv[ai][m] = s; }
        __builtin_amdgcn_sched_barrier(0);
        if (fq == 0) {
#pragma unroll
            for (int ai = 0; ai < 2; ++ai)
#pragma unroll
                for (int m = 0; m < 4; ++m) sx[wc * 256 + (xo0 - u.pm * BM) + ai * HALF + m * xos] = sv[ai][m];
        }
        asm volatile("s_waitcnt lgkmcnt(0)\n\ts_barrier" ::: "memory"); __builtin_amdgcn_sched_barrier(0);
        if (fq == 0 && !prb) {
#pragma unroll
            for (int hh = 0; hh < 2; ++hh) { const int rr = (wr * 4 + wc) * 16 + fr + 128 * hh;
                const float s = (sx[rr] + sx[256 + rr]) + (sx[512 + rr] + sx[768 + rr]);
                atomicAdd(ssq + u.pm * BM + rr, (unsigned long long)(s * SS_SCALE)); }
        }
    }
};
__device__ __forceinline__ float dpp_shr1(float old, float v) { return __int_as_float(__builtin_amdgcn_update_dpp(__float_as_int(old), __float_as_int(v), 0x111, 0xf, 0xf, false)); }
struct EpiUp {
    static constexpr bool PERM = true, AFTER_DRAIN = false, TWICE = false, HAS_PF = true;
    static constexpr int EPI_KIND = 3;
    static constexpr int SKEW = SKEW_UP;
    int l; PG8_LAS float* xch; PG8_LAS float* pf;
    __device__ __forceinline__ void prefetch(const Unit& u, int par, int wid, int lane) const {
        constexpr int NUPc = 11264, DFFc = 5632;
        const kargs_t ap = kargs(); unsigned char* ws = ap->ws;
        const unsigned dst = (unsigned)(uintptr_t)(pf + par * 2048) + wid * 1024;
        const char* src;
        if (wid < 2) src = (const char*)((const long long*)(ws + WS_SS) + (size_t)(2 * l + 1) * 16384 + u.pm * BM + wid * 128 + lane * 2);
        else if (wid < 4) src = (const char*)((const long long*)(ws + WS_BIAS) + BIAS_UP + (size_t)l * 2 * NUPc + (u.pm >= 32 ? NUPc : 0) + u.pn * BM + (wid - 2) * 128 + lane * 2);
        else { const int a = wid - 4, col = (lane < 32) ? u.pn * HALF + 4 * lane : DFFc + u.pn * HALF + 4 * (lane - 32);
            src = (const char*)((a < 3 ? (const float*)ap->in[17] + (size_t)l * 3 * NUPc + (size_t)a * NUPc : (const float*)ap->in[18] + (size_t)l * NUPc) + col); }
        unsigned keep; asm volatile("s_mov_b32 %0, m0\n\ts_mov_b32 m0, %2\n\ts_nop 0\n\tglobal_load_lds_dwordx4 %1, off\n\ts_mov_b32 m0, %0" : "=&s"(keep) : "v"(src), "s"((unsigned)__builtin_amdgcn_readfirstlane(dst)) : "memory");
    }
    __device__ __forceinline__ void operator()(f32x4 (&acc)[2][2][4][2], const Unit& u, int wr, int wc, int fr, int fq, int par) const {
        asm volatile("" : "+v"(fr), "+v"(fq)); asm volatile("" : "+s"(wr), "+s"(wc));
        const bool renorm = !(par & 2); par &= 1;
        const PG8_LAS unsigned char* pfb = (const PG8_LAS unsigned char*)(pf + par * 2048);
        constexpr int NUPc = 11264, DFFc = 5632;
        const kargs_t ap = kargs(); unsigned char* ws = ap->ws;
        bf16_t* ACT = (bf16_t*)(ws + WS_ACT); float* HU = (float*)(ws + WS_HU);
        const float* cw = (const float*)ap->in[17] + (size_t)l * 3 * NUPc; const float* cb = (const float*)ap->in[18] + (size_t)l * NUPc;
        const long long* ss = (const long long*)(ws + WS_SS) + (size_t)(2 * l + 1) * 16384; const long long* bias = (const long long*)(ws + WS_BIAS) + BIAS_UP + (size_t)l * 2 * NUPc;
        const int wid = wr * 4 + wc;
        if (renorm) apply_norm_lds(acc, (const PG8_LAS long long*)pfb, (const PG8_LAS long long*)(pfb + 2048) + wc * 32 + 8 * fq, wr * 64 + fr);
        if (fr == 15) {
#pragma unroll
            for (int ai = 0; ai < 2; ++ai)
#pragma unroll
                for (int bj = 0; bj < 2; ++bj)
#pragma unroll
                    for (int n = 0; n < 2; ++n) { *(PG8_LAS f32x4*)(xch + ((wid * 2 + ai) * 2 + 0) * 64 + bj * 32 + fq * 8 + n * 4) = acc[ai][bj][2][n]; *(PG8_LAS f32x4*)(xch + ((wid * 2 + ai) * 2 + 1) * 64 + bj * 32 + fq * 8 + n * 4) = acc[ai][bj][3][n]; }
        }
        { const int pc = u.pn * BM + wc * 32 + fq * 8;
          if (wr == 0 && fr == 0) {
#pragma unroll
            for (int k = 0; k < 2; ++k)
#pragma unroll
              for (int bj = 0; bj < 2; ++bj)
#pragma unroll
                for (int n = 0; n < 2; ++n) *(f32x4*)(HU + (size_t)(u.pm * 4 + k) * NUPc + pc + bj * HALF + n * 4) = acc[0][bj][k][n];
          }
          if (wr == 1 && fr == 15) {
#pragma unroll
            for (int k = 0; k < 2; ++k)
#pragma unroll
              for (int bj = 0; bj < 2; ++bj)
#pragma unroll
                for (int n = 0; n < 2; ++n) *(f32x4*)(HU + (size_t)(u.pm * 4 + 2 + k) * NUPc + pc + bj * HALF + n * 4) = acc[1][bj][2 + k][n];
          } }
        asm volatile("s_waitcnt lgkmcnt(0)\n\ts_barrier" ::: "memory"); __builtin_amdgcn_sched_barrier(0);
        const int j0 = u.pn * HALF + wc * 32 + fq * 8;
        const int row0 = u.pm * BM + wr * 64 + 4 * fr;
        bf16_t* const arow = ACT + (size_t)row0 * DFFc + j0;
        typedef float f32x2 __attribute__((ext_vector_type(2)));
#pragma unroll
        for (int n = 0; n < 2; ++n) {
            f32x4 w0[2], w1[2], w2[2], bb[2];
#pragma unroll
            for (int bj = 0; bj < 2; ++bj) { const PG8_LAS float* wp = (const PG8_LAS float*)(pfb + 4096) + bj * 128 + wc * 32 + fq * 8 + 4 * n;
                w0[bj] = *(const PG8_LAS f32x4*)wp; w1[bj] = *(const PG8_LAS f32x4*)(wp + 256); w2[bj] = *(const PG8_LAS f32x4*)(wp + 512); bb[bj] = *(const PG8_LAS f32x4*)(wp + 768); }
#pragma unroll
            for (int ai = 0; ai < 2; ++ai) {
                __builtin_amdgcn_sched_barrier(0);
                f32x4 y[2][4];
                const bool first = (wr == 0 && ai == 0);
                const int sw = (wr == 1) ? wc : 4 + wc, sai = (wr == 1) ? ai : ai - 1;
#pragma unroll
                for (int bj = 0; bj < 2; ++bj) {
                    f32x4 A = {0.f, 0.f, 0.f, 0.f}, B = A;
                    if (!first) { A = *(const PG8_LAS f32x4*)(xch + ((sw * 2 + sai) * 2 + 1) * 64 + bj * 32 + fq * 8 + n * 4); B = *(const PG8_LAS f32x4*)(xch + ((sw * 2 + sai) * 2 + 0) * 64 + bj * 32 + fq * 8 + n * 4); }
#pragma unroll
                    for (int e = 0; e < 4; e += 2) {
                        const f32x2 W0 = {w0[bj][e], w0[bj][e + 1]}, W1 = {w1[bj][e], w1[bj][e + 1]}, W2 = {w2[bj][e], w2[bj][e + 1]}, BB = {bb[bj][e], bb[bj][e + 1]};
                        const f32x2 U0 = {acc[ai][bj][0][n][e], acc[ai][bj][0][n][e + 1]}, U1 = {acc[ai][bj][1][n][e], acc[ai][bj][1][n][e + 1]}, U2 = {acc[ai][bj][2][n][e], acc[ai][bj][2][n][e + 1]}, U3 = {acc[ai][bj][3][n][e], acc[ai][bj][3][n][e + 1]};
                        const f32x2 D3 = {dpp_shr1(A[e], U3.x), dpp_shr1(A[e + 1], U3.y)}, D2 = {dpp_shr1(B[e], U2.x), dpp_shr1(B[e + 1], U2.y)};
                        const f32x2 Y0 = __builtin_elementwise_fma(W0, D2, __builtin_elementwise_fma(W1, D3, __builtin_elementwise_fma(W2, U0, BB)));
                        const f32x2 Y1 = __builtin_elementwise_fma(W0, D3, __builtin_elementwise_fma(W1, U0, __builtin_elementwise_fma(W2, U1, BB)));
                        const f32x2 Y2 = __builtin_elementwise_fma(W0, U0, __builtin_elementwise_fma(W1, U1, __builtin_elementwise_fma(W2, U2, BB)));
                        const f32x2 Y3 = __builtin_elementwise_fma(W0, U1, __builtin_elementwise_fma(W1, U2, __builtin_elementwise_fma(W2, U3, BB)));
                        y[bj][0][e] = Y0.x; y[bj][0][e + 1] = Y0.y; y[bj][1][e] = Y1.x; y[bj][1][e + 1] = Y1.y; y[bj][2][e] = Y2.x; y[bj][2][e + 1] = Y2.y; y[bj][3][e] = Y3.x; y[bj][3][e + 1] = Y3.y; }
                }
                float nl2e = -1.4426950408889634f, one = 1.f; asm volatile("" : "+v"(nl2e), "+v"(one));
#pragma unroll
                for (int m = 0; m < 4; ++m) { f32x4 a;
#pragma unroll
                    for (int e = 0; e < 4; e += 2) {
                        const f32x2 G = {y[0][m][e], y[0][m][e + 1]}, V = {y[1][m][e], y[1][m][e + 1]}; const f32x2 NG = G * (f32x2){nl2e, nl2e};
                        const f32x2 D = (f32x2){__builtin_amdgcn_exp2f(NG.x), __builtin_amdgcn_exp2f(NG.y)} + (f32x2){one, one};
                        const f32x2 R = (f32x2){__builtin_amdgcn_rcpf(D.x), __builtin_amdgcn_rcpf(D.y)}; const f32x2 O = (G * R) * V; a[e] = O.x; a[e + 1] = O.y; }
                    u32x2 w; w.x = cvt_pk_bf16(a[0], a[1]); w.y = cvt_pk_bf16(a[2], a[3]);
                    { bf16_t* p_ = arow; asm volatile("" : "+v"(p_));
                      *(__attribute__((address_space(1))) u32x2*)(p_ + (size_t)(ai * HALF + m) * DFFc + 4 * n) = w; } }
            }
        }
    }
};
}
#define GAS __attribute__((address_space(1)))
#define LAS __attribute__((address_space(3)))
typedef unsigned short bf16;
typedef unsigned v4u __attribute__((ext_vector_type(4)));
typedef float f32x4 __attribute__((ext_vector_type(4)));
typedef short bf16x8 __attribute__((ext_vector_type(8)));
typedef GAS unsigned gu32;
typedef GAS unsigned long long gu64;
#define RLX_AGENT __ATOMIC_RELAXED, __HIP_MEMORY_SCOPE_AGENT
#define LDS_WAIT() asm volatile("s_waitcnt lgkmcnt(0)" ::: "memory")
#define VM_WAIT() asm volatile("s_waitcnt vmcnt(0)" ::: "memory")
__device__ __forceinline__ unsigned long long rt() { return __builtin_amdgcn_s_memrealtime(); }
__device__ __forceinline__ unsigned f2bf(float f) { unsigned u = __builtin_bit_cast(unsigned, f); return (u + 0x7fffu + ((u >> 16) & 1u)) >> 16; }
__device__ __forceinline__ unsigned pk2(float lo, float hi) { return f2bf(lo) | (f2bf(hi) << 16); }

#define XB_TMO      128
#define XB_XCNT(j)  (256  + 64 * (j))
#define XB_XSUB(j)  (1280 + 64 * (j))
#define XB_XGEN(j)  (2304 + 64 * (j))
#define XB_TOP      3328
#define XB_TOPGEN   3392
#define XCD_BAR_WORDS 3456
#define XB_SPIN_CAP (1u << 23)

__device__ __forceinline__ unsigned xb_ld(unsigned* p)              { return __hip_atomic_load(p, __ATOMIC_RELAXED, __HIP_MEMORY_SCOPE_AGENT); }
__device__ __forceinline__ unsigned xb_add(unsigned* p, unsigned v) { return __hip_atomic_fetch_add(p, v, __ATOMIC_RELAXED, __HIP_MEMORY_SCOPE_AGENT); }
__device__ __forceinline__ unsigned xb_xcc_id() { return (unsigned)__builtin_amdgcn_s_getreg((3 << 11) | 20) & 0xFu; }
#define XB_SPIN(cond, bar) do { unsigned _sp = 0; while (cond) { __builtin_amdgcn_s_sleep(1); \
    if ((++_sp & 255u) == 0u) { if (xb_ld(&(bar)[XB_TMO])) break; if (_sp > XB_SPIN_CAP) { atomicAdd(&(bar)[XB_TMO], 1u); break; } } } } while (0)

struct XcdBarrier {
    unsigned* bar; unsigned x;
    volatile LAS unsigned* st;
};

__device__ __forceinline__ XcdBarrier xcd_barrier_post(unsigned* bar, volatile LAS unsigned* st) {
    XcdBarrier b; b.bar = bar; b.x = xb_xcc_id(); b.st = st;
    if (threadIdx.x == 0) (void)xb_add(&bar[XB_XCNT(b.x)], 1u);
    return b;
}
__device__ __forceinline__ void xcd_barrier_complete(unsigned* bar, unsigned x, unsigned& nloc, unsigned& nx) {
    const unsigned G = gridDim.x * gridDim.y * gridDim.z;
    unsigned sum, cnt, mine, sp = 0u;
    for (;;) {
        sum = 0u; cnt = 0u; mine = 0u;
#pragma unroll
        for (unsigned j = 0; j < 16; ++j) { const unsigned c = xb_ld(&bar[XB_XCNT(j)]); sum += c; cnt += (c > 0u) ? 1u : 0u; mine = (j == x) ? c : mine; }
        if (sum == G) break;
        __builtin_amdgcn_s_sleep(1);
        if ((++sp & 255u) == 0u) { if (xb_ld(&bar[XB_TMO])) break; if (sp > XB_SPIN_CAP) { atomicAdd(&bar[XB_TMO], 1u); break; } }
    }
    nloc = mine > 0u ? mine : 1u; nx = cnt > 0u ? cnt : 1u;
}

__device__ __forceinline__ void xcd_barrier(const XcdBarrier& b) {
    asm volatile("s_waitcnt vmcnt(0)" ::: "memory");
    __syncthreads();
    if (threadIdx.x == 0) {
        unsigned* bar = b.bar;
        __builtin_amdgcn_s_waitcnt(0);
        unsigned nloc = b.st[0], nx = b.st[1];
        if (nloc == 0u) { xcd_barrier_complete(bar, b.x, nloc, nx); b.st[0] = nloc; b.st[1] = nx; }
        const unsigned old = xb_add(&bar[XB_XSUB(b.x)], 1u);
        const unsigned gen = old / nloc;
        if (old + 1u == (gen + 1u) * nloc) {
            __builtin_amdgcn_fence(__ATOMIC_RELEASE, "agent");
            asm volatile("s_waitcnt vmcnt(0)" ::: "memory");
            const unsigned og = xb_add(&bar[XB_TOP], 1u);
            const unsigned tg = og / nx;
            if (og + 1u == (tg + 1u) * nx) xb_add(&bar[XB_TOPGEN], 1u);
            else XB_SPIN(xb_ld(&bar[XB_TOPGEN]) == tg, bar);
            __builtin_amdgcn_fence(__ATOMIC_ACQUIRE, "agent");
            xb_add(&bar[XB_XGEN(b.x)], 1u);
            asm volatile("s_waitcnt vmcnt(0)" ::: "memory");
        } else {
            XB_SPIN(xb_ld(&bar[XB_XGEN(b.x)]) == gen, bar);
            __builtin_amdgcn_fence(__ATOMIC_ACQUIRE, "agent");
            asm volatile("s_waitcnt vmcnt(0)" ::: "memory");
        }
    }
    __syncthreads();
}
#include <hip/hip_bf16.h>
#include <cmath>
namespace fox_body {
using bf16=__hip_bfloat16;
using bf16x8=__attribute__((ext_vector_type(8)))short;
using s16x4=__attribute__((ext_vector_type(4)))short;
using f32x16=__attribute__((ext_vector_type(16)))float;
using u32x4=__attribute__((ext_vector_type(4)))unsigned;
constexpr int BATCH=2,NHEAD=32,SEQ=8192,D=64,DMQ=6144,DMO=2048;
constexpr float SKIP_T=40.f;
constexpr int NW=8,QBLK=32,QB=QBLK*NW,KVBLK=64,NQB=SEQ/QB;
constexpr int ATTN_UNIT_ROWS=QB;
__device__ __forceinline__ int crow(int r,int hi){return (r&3)+8*(r>>2)+4*hi;}
#define SBAR() __builtin_amdgcn_sched_barrier(0)
__device__ __forceinline__ void cmask(f32x16&p0,f32x16&p1,int jb,int qrel,int hi){
  const float NEG=-INFINITY; int kb=64*jb+4*hi;
  #pragma unroll
  for(int r=0;r<16;++r){int kv=kb+(r&3)+8*(r>>2); if(kv>qrel)p0[r]=NEG; if(kv+32>qrel)p1[r]=NEG;}
}

constexpr int NSLOT=3, SLOTB=8192;
constexpr int LDS_K=0, LDS_V=NSLOT*SLOTB, LDS_WS=2*NSLOT*SLOTB, LDS_OST=LDS_WS+NW*64*4, LDS_FROW=LDS_OST+NW*4096+2048, LDS_BYTES=LDS_FROW+SEQ*4;
constexpr float C2=0.125f*1.4426950408889634f;
__device__ __forceinline__ void glds16(const void*gsrc,unsigned lds_dst){unsigned keep;
  asm volatile("s_mov_b32 %0, m0\n\ts_mov_b32 m0, %2\n\ts_nop 0\n\tglobal_load_lds_dwordx4 %1, off\n\ts_mov_b32 m0, %0":"=&s"(keep):"v"(gsrc),"s"(lds_dst):"memory");}
__device__ __forceinline__ float max3f(float a,float b,float c){float r;asm("v_max3_f32 %0, %1, %2, %3":"=v"(r):"v"(a),"v"(b),"v"(c));return r;}
__device__ __forceinline__ float max2f(float a,float b){float r;asm("v_max_f32_e32 %0, %1, %2":"=v"(r):"v"(a),"v"(b));return r;}
__device__ __forceinline__ float fadd_s(float a,float b){float r;asm("v_add_f32_e32 %0, %1, %2":"=v"(r):"v"(a),"v"(b));return r;}
__device__ __forceinline__ float fsub_s(float a,float b){float r;asm("v_sub_f32_e32 %0, %1, %2":"=v"(r):"v"(a),"v"(b));return r;}
typedef float f32x2_t __attribute__((ext_vector_type(2))); typedef __bf16 bf16x2_t __attribute__((ext_vector_type(2)));
__device__ __forceinline__ unsigned cvtpk_s(float lo,float hi){f32x2_t v={lo,hi};bf16x2_t b=__builtin_convertvector(v,bf16x2_t);return __builtin_bit_cast(unsigned,b);}
#define WAIT_BAR(N) asm volatile("s_waitcnt vmcnt(" #N ") lgkmcnt(0)\n\ts_barrier":::"memory")

__device__ __forceinline__ void qkt(f32x16&p0,f32x16&p1,const char*Kslot,const bf16x8*qr,int r32,int hi){
  const char*kb=Kslot+hi*1024+r32*16;
  #pragma unroll
  for(int d0=0;d0<4;++d0){
    const bf16x8 b0=*reinterpret_cast<const bf16x8*>(kb+d0*2048);
    const bf16x8 b1=*reinterpret_cast<const bf16x8*>(kb+d0*2048+512);
    p0=__builtin_amdgcn_mfma_f32_32x32x16_bf16(b0,qr[d0],p0,0,0,0);p1=__builtin_amdgcn_mfma_f32_32x32x16_bf16(b1,qr[d0],p1,0,0,0);}
}
typedef __attribute__((address_space(3))) const char* lds_cptr;
typedef short v4i16_t __attribute__((ext_vector_type(4)));
__device__ __forceinline__ void kload8(bf16x8*kf,lds_cptr kp){
  kf[0]=*(const __attribute__((address_space(3))) bf16x8*)(kp);      kf[1]=*(const __attribute__((address_space(3))) bf16x8*)(kp+512);
  kf[2]=*(const __attribute__((address_space(3))) bf16x8*)(kp+2048); kf[3]=*(const __attribute__((address_space(3))) bf16x8*)(kp+2560);
  kf[4]=*(const __attribute__((address_space(3))) bf16x8*)(kp+4096); kf[5]=*(const __attribute__((address_space(3))) bf16x8*)(kp+4608);
  kf[6]=*(const __attribute__((address_space(3))) bf16x8*)(kp+6144); kf[7]=*(const __attribute__((address_space(3))) bf16x8*)(kp+6656);
}
__device__ __forceinline__ void kload2(bf16x8*kf,lds_cptr kp,int j){ kf[2*j]=*(const __attribute__((address_space(3))) bf16x8*)(kp+j*2048); kf[2*j+1]=*(const __attribute__((address_space(3))) bf16x8*)(kp+j*2048+512); }
__device__ __forceinline__ s16x4 vtr(lds_cptr p){ return __builtin_bit_cast(s16x4,__builtin_amdgcn_ds_read_tr16_b64_v4i16((__attribute__((address_space(3))) v4i16_t*)p)); }
__device__ __forceinline__ float rowmax(const f32x16&p0,const f32x16&p1){
  float a=max3f(p0[0],p0[1],p1[0]),b=max3f(p0[2],p0[3],p1[1]);a=max3f(a,p1[2],p1[3]);
  #pragma unroll
  for(int r=4;r<16;r+=4){a=max3f(a,p0[r],p0[r+1]);b=max3f(b,p0[r+2],p0[r+3]);a=max3f(a,p1[r],p1[r+1]);b=max3f(b,p1[r+2],p1[r+3]);}
  const float m=max2f(a,b);
  auto rr=__builtin_amdgcn_permlane32_swap(__float_as_uint(m),__float_as_uint(m),false,false);
  return max2f(__uint_as_float(rr[0]),__uint_as_float(rr[1]));
}
__device__ __forceinline__ void pv2(f32x16*o,int vb,const int ks0,bf16x8 pa0,bf16x8 pa1){
  s16x4 lo[2][2],hi[2][2];
  #pragma unroll
  for(int d0=0;d0<2;++d0)
    #pragma unroll
    for(int ks=0;ks<2;++ks){
      if(ks0==0){ asm volatile("ds_read_b64_tr_b16 %0,%1 offset:%c2":"=&v"(lo[d0][ks]):"v"(vb),"i"(d0*4096+ks*1024):"memory"); asm volatile("ds_read_b64_tr_b16 %0,%1 offset:%c2":"=&v"(hi[d0][ks]):"v"(vb),"i"(d0*4096+ks*1024+512):"memory"); }
      else      { asm volatile("ds_read_b64_tr_b16 %0,%1 offset:%c2":"=&v"(lo[d0][ks]):"v"(vb),"i"(d0*4096+(ks+2)*1024):"memory"); asm volatile("ds_read_b64_tr_b16 %0,%1 offset:%c2":"=&v"(hi[d0][ks]):"v"(vb),"i"(d0*4096+(ks+2)*1024+512):"memory"); } }
  asm volatile("s_waitcnt lgkmcnt(0)":::"memory");SBAR();
  #pragma unroll
  for(int d0=0;d0<2;++d0){
    o[d0]=__builtin_amdgcn_mfma_f32_32x32x16_bf16(pa0,(bf16x8){lo[d0][0][0],lo[d0][0][1],lo[d0][0][2],lo[d0][0][3],hi[d0][0][0],hi[d0][0][1],hi[d0][0][2],hi[d0][0][3]},o[d0],0,0,0);
    o[d0]=__builtin_amdgcn_mfma_f32_32x32x16_bf16(pa1,(bf16x8){lo[d0][1][0],lo[d0][1][1],lo[d0][1][2],lo[d0][1][3],hi[d0][1][0],hi[d0][1][1],hi[d0][1][2],hi[d0][1][3]},o[d0],0,0,0); }
}
__device__ __forceinline__ void pv(f32x16*o,int vb,bf16x8 pa0,bf16x8 pa1,bf16x8 pa2,bf16x8 pa3){
  #pragma unroll
  for(int d0=0;d0<2;++d0){s16x4 lo[4],hi[4];
    #pragma unroll
    for(int ks=0;ks<4;++ks){
      asm volatile("ds_read_b64_tr_b16 %0,%1 offset:%c2":"=&v"(lo[ks]):"v"(vb),"i"(d0*4096+ks*1024):"memory");
      asm volatile("ds_read_b64_tr_b16 %0,%1 offset:%c2":"=&v"(hi[ks]):"v"(vb),"i"(d0*4096+ks*1024+512):"memory");}
    asm volatile("s_waitcnt lgkmcnt(0)":::"memory");SBAR();
    #define PK(k) (bf16x8){lo[k][0],lo[k][1],lo[k][2],lo[k][3],hi[k][0],hi[k][1],hi[k][2],hi[k][3]}
    o[d0]=__builtin_amdgcn_mfma_f32_32x32x16_bf16(pa0,PK(0),o[d0],0,0,0);
    o[d0]=__builtin_amdgcn_mfma_f32_32x32x16_bf16(pa1,PK(1),o[d0],0,0,0);
    o[d0]=__builtin_amdgcn_mfma_f32_32x32x16_bf16(pa2,PK(2),o[d0],0,0,0);
    o[d0]=__builtin_amdgcn_mfma_f32_32x32x16_bf16(pa3,PK(3),o[d0],0,0,0);
    #undef PK
  }
}

#ifndef ATTN_STORE16
#define ATTN_STORE16(p,v) (*(u32x4*)(p)=(v))
#endif
template<int THRL> __device__ __forceinline__ void attn_unit(int b,int h,int qb,const bf16*Q,const bf16*__restrict__ K,const bf16*__restrict__ V,bf16*O,const float*__restrict__ Fg,const unsigned*__restrict__ qk2,char*shm,const int wv){
  int tid_=wv*64+lane_id_fresh(); const int tid=tid_,lane=tid&63,r32=lane&31,hi=lane>>5; const int wid=__builtin_amdgcn_readfirstlane(tid>>6);
  const long rowbase=(long)b*SEQ; const int q0=qb*QB;
  const bf16*Qw=Q+(rowbase+q0+wid*QBLK)*DMQ+h*D;
  const float* Fh=Fg+(long)(b*NHEAD+h)*SEQ;
  int t0=0;
  { const unsigned qa=qk2[(b*NHEAD+h)*4+0],qb2=qk2[(b*NHEAD+h)*4+1],ka=qk2[(b*NHEAD+h)*4+2],kb=qk2[(b*NHEAD+h)*4+3];
    const float S2=2.04f*sqrtf((__uint_as_float(qa)+__uint_as_float(qb2))*(__uint_as_float(ka)+__uint_as_float(kb)));
    const float thrF=Fh[q0]+(SKIP_T+S2)*0.6931471805599453f;
    const int NT0=(q0+QB)/KVBLK; const int ta=lane, tb=lane+64;
    const bool ca=(ta<NT0-4)&&(Fh[64*ta+63]>=thrF), cb=(tb<NT0-4)&&(Fh[64*tb+63]>=thrF);
    t0=__builtin_popcountll(__ballot(ca))+__builtin_popcountll(__ballot(cb)); t0&=~1; if(t0>NT0-4)t0=NT0-4; t0=__builtin_amdgcn_readfirstlane(t0); }
  const bf16*Kh=K+(rowbase+64*t0)*DMQ+h*D,*Vh=V+(rowbase+64*t0)*DMQ+h*D;
  const __attribute__((address_space(3))) char* shm3f=(__attribute__((address_space(3))) char*)shm; const unsigned lds0=(unsigned)(uintptr_t)shm;
  float*wsf=(float*)(shm+LDS_WS)+wid*64;
  const bf16*ksrc=Kh+(long)lane*DMQ+wid*8;
  const bf16*vsrc=Vh+(long)(16*(wid&3)+(lane>>2))*DMQ+(wid>>2)*32+(lane&3)*8;
  const unsigned kdst=lds0+LDS_K+wid*1024, vdst=lds0+LDS_V+wid*1024;
  #define DMA_K(t,slot) glds16(ksrc+(long)(t)*KVBLK*DMQ,(unsigned)__builtin_amdgcn_readfirstlane(kdst+(slot)))
  #define DMA_V(t,slot) glds16(vsrc+(long)(t)*KVBLK*DMQ,(unsigned)__builtin_amdgcn_readfirstlane(vdst+(slot)))
  const int vb0=(int)(lds0+LDS_V)+((lane>>4)&1)*32+(lane&3)*8+(4*hi+((lane&15)>>2))*64;
  const char*Kbase=shm+LDS_K; bf16x8 kf[8];
  const lds_cptr shm3=(lds_cptr)shm; const lds_cptr kp0=shm3+LDS_K+hi*1024+r32*16; const lds_cptr vp0=shm3+LDS_V+((lane>>4)&1)*32+(lane&3)*8+(4*hi+((lane&15)>>2))*64;
  const int NT=(q0+QB)/KVBLK-t0;
  { typedef float f32x4_t __attribute__((ext_vector_type(4))); const f32x4_t*fg=(const f32x4_t*)(Fh+64*t0); __attribute__((address_space(3))) f32x4_t*fl=(__attribute__((address_space(3))) f32x4_t*)(shm3f+LDS_FROW);
    for(int i=tid;i<(q0+QB-64*t0)/4;i+=NW*64){f32x4_t v=fg[i]; fl[i]=v*1.4426950408889634f;} }
  DMA_K(0,0);DMA_V(0,0);DMA_K(1,SLOTB);
  bf16x8 qr[4];
  #pragma unroll
  for(int d0=0;d0<4;++d0)qr[d0]=*reinterpret_cast<const bf16x8*>(&Qw[(long)r32*DMQ+d0*16+hi*8]);
  float mhat=0.f,l_reg=0.f;f32x16 o[2];o[0]=f32x16{};o[1]=f32x16{};
  typedef __attribute__((address_space(3))) const float* lds_fptr; typedef float f32x4_t __attribute__((ext_vector_type(4))); typedef float f32x2_t __attribute__((ext_vector_type(2)));
  const lds_fptr frow=(lds_fptr)(shm3f+LDS_FROW)+4*hi;
  float fq2=0.f, nb=0.f;
  #define FPK(lo_,hi_,src_) asm("v_pk_add_f32 %0, %2, %3 neg_lo:[0,1] neg_hi:[0,1]\n\tv_pk_add_f32 %1, %2, %4 neg_lo:[0,1] neg_hi:[0,1]" : "=&v"(lo_), "=&v"(hi_) : "v"(n2_), "v"(__builtin_shufflevector(src_,src_,0,1)), "v"(__builtin_shufflevector(src_,src_,2,3)))
  #define FINIT(C0,C1,t) do{ const lds_fptr fp_=frow+(t)*64; const f32x2_t n2_={nb,nb}; f32x2_t c_[16]; \
      _Pragma("unroll") for(int g_=0;g_<4;++g_){ const f32x4_t a_=*(const __attribute__((address_space(3))) f32x4_t*)(fp_+8*g_), b_=*(const __attribute__((address_space(3))) f32x4_t*)(fp_+32+8*g_); \
        FPK(c_[2*g_],c_[2*g_+1],a_); FPK(c_[8+2*g_],c_[8+2*g_+1],b_); } \
      C0=__builtin_shufflevector(__builtin_shufflevector(__builtin_shufflevector(c_[0],c_[1],0,1,2,3),__builtin_shufflevector(c_[2],c_[3],0,1,2,3),0,1,2,3,4,5,6,7),__builtin_shufflevector(__builtin_shufflevector(c_[4],c_[5],0,1,2,3),__builtin_shufflevector(c_[6],c_[7],0,1,2,3),0,1,2,3,4,5,6,7),0,1,2,3,4,5,6,7,8,9,10,11,12,13,14,15); \
      C1=__builtin_shufflevector(__builtin_shufflevector(__builtin_shufflevector(c_[8],c_[9],0,1,2,3),__builtin_shufflevector(c_[10],c_[11],0,1,2,3),0,1,2,3,4,5,6,7),__builtin_shufflevector(__builtin_shufflevector(c_[12],c_[13],0,1,2,3),__builtin_shufflevector(c_[14],c_[15],0,1,2,3),0,1,2,3,4,5,6,7),0,1,2,3,4,5,6,7,8,9,10,11,12,13,14,15); }while(0)
  const int qrel=wid*QBLK+r32;
  #define CMASK(P0,P1,t) do{int jb_=(t)-(NT-4); if(jb_>=0)cmask(P0,P1,jb_,qrel,hi);}while(0)
  bool resc=false;
  #define START(P0,P1) do{ const float rm=rowmax(P0,P1); resc=false; \
    { const float dl=rm; mhat=fadd_s(mhat,dl); \
      _Pragma("unroll") for(int r=0;r<16;++r){P0[r]=fsub_s(P0[r],dl);P1[r]=fsub_s(P1[r],dl);} \
      nb=fq2-mhat; } \
    _Pragma("unroll") for(int r=0;r<16;++r)P0[r]=__builtin_amdgcn_exp2f(P0[r]); }while(0)
  #define RESC() do{ if(resc){ asm volatile("s_waitcnt lgkmcnt(0)":::"memory"); \
      _Pragma("unroll") for(int d_=0;d_<2;++d_) _Pragma("unroll") for(int r=0;r<16;++r)o[d_][r]*=wsf[crow(r,hi)]; } }while(0)
  f32x16 pA0,pA1,pB0,pB1;
  int sl_prev=0,sl_cur=0,sl_next=SLOTB;
  #define ROT() do{sl_prev=sl_cur;sl_cur=sl_next;sl_next=(sl_next==(NSLOT-1)*SLOTB)?0:sl_next+SLOTB;}while(0)
  DMA_K(2,2*SLOTB);
  WAIT_BAR(3);
  fq2=((lds_fptr)(shm3f+LDS_FROW))[q0-64*t0+wid*QBLK+r32]; nb=fq2;
  FINIT(pA0,pA1,0);
  qkt(pA0,pA1,Kbase,qr,r32,hi);asm volatile("s_nop 15\n\ts_nop 7":"+v"(pA0),"+v"(pA1));CMASK(pA0,pA1,0);
  START(pA0,pA1);
  _Pragma("unroll") for(int r=0;r<16;++r)pA1[r]=__builtin_amdgcn_exp2f(pA1[r]);
  WAIT_BAR(0);
  DMA_K(3,0);DMA_V(1,SLOTB);
  ROT();
  kload8(kf,kp0+sl_cur);
  WAIT_BAR(2);
  s16x4 vlo[8],vhi[8]; u32x4 pw0,pw1,pw2,pw3;
  #define PKW(P,B) cvtpk_s(P[B],P[B+1])
  #define PAF(k) __builtin_bit_cast(bf16x8,pw##k)
  #define VFR(i) (bf16x8){vlo[i][0],vlo[i][1],vlo[i][2],vlo[i][3],vhi[i][0],vhi[i][1],vhi[i][2],vhi[i][3]}
  #define PIN(x) asm volatile("":"+v"(x))
  #define MX3(a,b,c) __builtin_fmaxf(__builtin_fmaxf((a),(b)),(c))
  #define SPK(A0,A1) asm volatile("v_pk_add_f32 %0, %0, %1" : "+v"(sacc) : "v"((f32x2_t){A0,A1}))
  #define GAPA(MF,A0,A1,A2,A3,W0,W1,PW) do{ MF; SPK(A0,A1); SPK(A2,A3); W0; W1; PIN(PW); SBAR(); }while(0)
  #define GAPA1(MF,A0,A1,W0,W1,PW) do{ MF; SPK(A0,A1); W0; W1; PIN(PW); SBAR(); }while(0)
  #define EX(v) __builtin_amdgcn_exp2f(v)
  #define GAPB(MF,X,B) do{ MF; X[B]=EX(X[B]); X[B+1]=EX(X[B+1]); X[B+2]=EX(X[B+2]); X[B+3]=EX(X[B+3]); PIN(X); SBAR(); }while(0)
  #define VRD(i) do{ vlo[i]=vtr(vp_+(((i)>>2)*4096+((i)&3)*1024)); vhi[i]=vtr(vp_+(((i)>>2)*4096+((i)&3)*1024+512)); }while(0)
  #define KRD(G,j) do{ if(G){ kload2(kf,kp0+sl_next,j); SBAR(); } }while(0)
  #define STEP(C0,C1,P0,P1,t,GK,GV,GL) do{ SBAR(); \
    const lds_cptr vp_=vp0+sl_prev; \
    FINIT(C0,C1,t); SBAR(); \
    VRD(0); SBAR(); f32x2_t sacc={P0[0],P0[1]}; \
    GAPA(C0=__builtin_amdgcn_mfma_f32_32x32x16_bf16(kf[0],qr[0],C0,0,0,0), P0[2],P0[3],P0[4],P0[5],     pw0[0]=PKW(P0,0), pw0[1]=PKW(P0,2), pw0); \
    VRD(4); SBAR(); GAPA(C1=__builtin_amdgcn_mfma_f32_32x32x16_bf16(kf[1],qr[0],C1,0,0,0), P0[6],P0[7],P0[8],P0[9],     pw0[2]=PKW(P0,4), pw0[3]=PKW(P0,6), pw0); \
    VRD(1); SBAR(); GAPA(C0=__builtin_amdgcn_mfma_f32_32x32x16_bf16(kf[2],qr[1],C0,0,0,0),   P0[10],P0[11],P0[12],P0[13], pw1[0]=PKW(P0,8), pw1[1]=PKW(P0,10), pw1); \
    VRD(5); SBAR(); GAPA(C1=__builtin_amdgcn_mfma_f32_32x32x16_bf16(kf[3],qr[1],C1,0,0,0),   P0[14],P0[15],P1[0],P1[1],   pw1[2]=PKW(P0,12),pw1[3]=PKW(P0,14), pw1); \
    VRD(2); SBAR(); GAPA(C0=__builtin_amdgcn_mfma_f32_32x32x16_bf16(kf[4],qr[2],C0,0,0,0),   P1[2],P1[3],P1[4],P1[5],     pw2[0]=PKW(P1,0), pw2[1]=PKW(P1,2), pw2); \
    VRD(6); SBAR(); GAPA(C1=__builtin_amdgcn_mfma_f32_32x32x16_bf16(kf[5],qr[2],C1,0,0,0),   P1[6],P1[7],P1[8],P1[9],     pw2[2]=PKW(P1,4), pw2[3]=PKW(P1,6), pw2); \
    VRD(3); SBAR(); GAPA(C0=__builtin_amdgcn_mfma_f32_32x32x16_bf16(kf[6],qr[3],C0,0,0,0),   P1[10],P1[11],P1[12],P1[13], pw3[0]=PKW(P1,8), pw3[1]=PKW(P1,10), pw3); \
    VRD(7); SBAR(); GAPA1(C1=__builtin_amdgcn_mfma_f32_32x32x16_bf16(kf[7],qr[3],C1,0,0,0),  P1[14],P1[15],               pw3[2]=PKW(P1,12),pw3[3]=PKW(P1,14), pw3); \
    l_reg+=sacc.x+sacc.y; \
    if(GK){DMA_K((t)+3,sl_cur);} if(GV){DMA_V((t)+1,sl_next);} \
    CMASK(C0,C1,t); \
    { float a=MX3(C0[0],C0[1],C1[0]),b=MX3(C0[2],C0[3],C1[1]); a=MX3(a,C1[2],C1[3]); \
      _Pragma("unroll") for(int r=4;r<16;r+=4){a=MX3(a,C0[r],C0[r+1]);b=MX3(b,C0[r+2],C0[r+3]);a=MX3(a,C1[r],C1[r+1]);b=MX3(b,C1[r+2],C1[r+3]);} \
      float rm=__builtin_fmaxf(a,b); { auto rr=__builtin_amdgcn_permlane32_swap(__float_as_uint(rm),__float_as_uint(rm),false,false); rm=__builtin_fmaxf(__uint_as_float(rr[0]),__uint_as_float(rr[1])); } \
      resc=false; \
      if(__builtin_expect(__any(rm>(float)THRL),0)){ const float dl=__builtin_fmaxf(rm,0.f); mhat+=dl; \
        _Pragma("unroll") for(int r=0;r<16;++r){C0[r]-=dl;C1[r]-=dl;} \
        nb=fq2-mhat; \
        const float f=__builtin_amdgcn_exp2f(-dl); l_reg*=f; if(hi==0)wsf[r32]=f; resc=true; } } \
    SBAR(); \
    GAPB(o[0]=__builtin_amdgcn_mfma_f32_32x32x16_bf16(PAF(0),VFR(0),o[0],0,0,0), C0,0); \
    GAPB(o[1]=__builtin_amdgcn_mfma_f32_32x32x16_bf16(PAF(0),VFR(4),o[1],0,0,0), C0,4); \
    KRD(GL,0); GAPB(o[0]=__builtin_amdgcn_mfma_f32_32x32x16_bf16(PAF(1),VFR(1),o[0],0,0,0), C0,8); \
    KRD(GL,1); GAPB(o[1]=__builtin_amdgcn_mfma_f32_32x32x16_bf16(PAF(1),VFR(5),o[1],0,0,0), C0,12); \
    KRD(GL,2); GAPB(o[0]=__builtin_amdgcn_mfma_f32_32x32x16_bf16(PAF(2),VFR(2),o[0],0,0,0), C1,0); \
    KRD(GL,3); GAPB(o[1]=__builtin_amdgcn_mfma_f32_32x32x16_bf16(PAF(2),VFR(6),o[1],0,0,0), C1,4); \
    GAPB(o[0]=__builtin_amdgcn_mfma_f32_32x32x16_bf16(PAF(3),VFR(3),o[0],0,0,0), C1,8); \
    GAPB(o[1]=__builtin_amdgcn_mfma_f32_32x32x16_bf16(PAF(3),VFR(7),o[1],0,0,0), C1,12); \
    }while(0)
  int t=1;
  #undef CMASK
  #define CMASK(P0,P1,t) do{}while(0)
  for(;t+5<NT;t+=2){
    STEP(pB0,pB1,pA0,pA1,t,true,true,true);     WAIT_BAR(2); RESC(); ROT();
    STEP(pA0,pA1,pB0,pB1,t+1,true,true,true);   WAIT_BAR(2); RESC(); ROT();
  }
  #undef CMASK
  #define CMASK(P0,P1,t) do{int jb_=(t)-(NT-4); if(jb_>=0)cmask(P0,P1,jb_,qrel,hi);}while(0)
  #define ENDW(tt) do{ if((tt)+3<NT){WAIT_BAR(2);} else if((tt)+2<NT){WAIT_BAR(1);} else {WAIT_BAR(0);} }while(0)
  for(;t+1<NT;t+=2){
    STEP(pB0,pB1,pA0,pA1,t,(t+3<NT),(t+1<NT),(t+1<NT));       ENDW(t);   RESC(); ROT();
    STEP(pA0,pA1,pB0,pB1,t+1,(t+4<NT),(t+2<NT),(t+2<NT));     ENDW(t+1); RESC(); ROT();
  }
  STEP(pB0,pB1,pA0,pA1,NT-1,false,false,false); RESC();
  { float sacc=pB0[0]+pB0[1]; _Pragma("unroll") for(int r=2;r<16;++r)sacc+=pB0[r]; _Pragma("unroll") for(int r=0;r<16;++r)sacc+=pB1[r]; l_reg+=sacc;
    pw0=(u32x4){PKW(pB0,0),PKW(pB0,2),PKW(pB0,4),PKW(pB0,6)};pw1=(u32x4){PKW(pB0,8),PKW(pB0,10),PKW(pB0,12),PKW(pB0,14)};pw2=(u32x4){PKW(pB1,0),PKW(pB1,2),PKW(pB1,4),PKW(pB1,6)};pw3=(u32x4){PKW(pB1,8),PKW(pB1,10),PKW(pB1,12),PKW(pB1,14)};
    SBAR(); pv(o,vb0+sl_cur,PAF(0),PAF(1),PAF(2),PAF(3)); }
  #undef PKW
  #undef PAF
  #undef VFR
  #undef PIN
  #undef MX3
  #undef GAPA
  #undef GAPB
  #undef EX
  #undef VRD
  #undef KRD
  #undef STEP
  #undef ENDW
  {auto rr=__builtin_amdgcn_permlane32_swap(__float_as_uint(l_reg),__float_as_uint(l_reg),false,false);l_reg=__uint_as_float(rr[0])+__uint_as_float(rr[1]);}
  if(hi==0)wsf[32+r32]=l_reg;asm volatile("s_waitcnt lgkmcnt(0)":::"memory");
  float rli[16];
  #pragma unroll
  for(int r=0;r<16;++r)rli[r]=__builtin_amdgcn_rcpf(wsf[32+crow(r,hi)]);
  bf16*Ow=O+(rowbase+q0+wid*QBLK)*DMO+h*D;
  { bf16*stg=(bf16*)(shm+LDS_OST)+wid*2048;
    #pragma unroll
    for(int r=0;r<16;++r){const int orow=crow(r,hi);
      #pragma unroll
      for(int d0=0;d0<2;++d0)stg[orow*64+d0*32+r32]=__float2bfloat16(o[d0][r]*rli[r]);}
    asm volatile("s_waitcnt lgkmcnt(0)":::"memory");
    #pragma unroll
    for(int i=0;i<4;++i){const int row=i*8+(lane>>3),ch=lane&7; const u32x4 v=*(const u32x4*)(stg+row*64+ch*8); ATTN_STORE16(Ow+(long)row*DMO+ch*8,v);} }
  asm volatile("s_waitcnt lgkmcnt(0)\n\ts_barrier":::"memory");
  #undef DMA_K
  #undef DMA_V
  #undef CMASK
  #undef START
  #undef RESC
  #undef FINIT
  #undef ROT
}
constexpr int LDS_QSLOT=LDS_BYTES, ATTN_LDS_BYTES=LDS_BYTES+64;
struct AttnTensors { const bf16* Q; const bf16* K; const bf16* V; bf16* O; const float* F; const unsigned* qk2; unsigned* queue; };
struct AttnUnit { int bh; int qb; };
struct StaticOrder {
  int vcu, G;
  __device__ __forceinline__ explicit StaticOrder(int grid,int block):vcu((grid%8==0)?(block%8)*(grid/8)+block/8:block),G(grid){}
  __device__ __forceinline__ bool next(int i,AttnUnit&u)const{
    if(G==256){ if(i>=8)return false; const int s=vcu&3, o=8*(i>>1); u.bh=vcu>>2; u.qb=(i&1)?o+7-s:o+s; return true; }
    const int idx=i*G+vcu; if(idx>=BATCH*NHEAD*NQB)return false; u.bh=idx/NQB; u.qb=NQB-1-idx%NQB; return true; }
  __device__ __forceinline__ void a_ready(const AttnUnit&)const{}
  __device__ __forceinline__ void done(const AttnUnit&)const{}
};
template<int THRL=8> __device__ __forceinline__ void attn_phase(char*lds,const AttnTensors&T,const int wv){
  const int tid=wv*64+lane_id_fresh();
  volatile __attribute__((address_space(3))) int* qs=(volatile __attribute__((address_space(3))) int*)((__attribute__((address_space(3))) char*)lds+LDS_QSLOT);
  int nxt=0;
  if(tid==0){ nxt=(int)__hip_atomic_fetch_add(T.queue,1u,__ATOMIC_RELAXED,__HIP_MEMORY_SCOPE_AGENT); qs[0]=nxt; }
  asm volatile("s_waitcnt vmcnt(0) lgkmcnt(0)\n\ts_barrier":::"memory");
  int cur=qs[0]; int par=1;
  while(cur<BATCH*NHEAD*NQB){
    if(tid==0) nxt=(int)__hip_atomic_fetch_add(T.queue,1u,__ATOMIC_RELAXED,__HIP_MEMORY_SCOPE_AGENT);
    const int qb=NQB-1-cur/(BATCH*NHEAD), bh=cur%(BATCH*NHEAD);
    attn_unit<THRL>(bh/NHEAD,bh%NHEAD,qb,T.Q,T.K,T.V,T.O,T.F,T.qk2,lds,wv);
    if(tid==0) qs[par]=nxt;
    asm volatile("s_waitcnt vmcnt(0) lgkmcnt(0)\n\ts_barrier":::"memory");
    cur=qs[par]; par^=1;
  }
}

constexpr int SWA_SET=2*NSLOT*SLOTB;
constexpr int SWA_WS=2*SWA_SET, SWA_OST=SWA_WS+NW*64*4, SWA_LDS_BYTES=SWA_OST+NW*4096;
__device__ __forceinline__ void swa_issue(int u,const bf16*Y,unsigned lds_set,int lane,int wid){
  constexpr int PQ=2560; const int q0=(u%(SEQ/64))*64, hk=(u/(SEQ/64))&3, b=u/(4*(SEQ/64)); const long rowbase=(long)b*SEQ;
  const bf16*Kh=Y+rowbase*PQ+2048+hk*64,*Vh=Y+rowbase*PQ+2304+hk*64;
  #pragma unroll
  for(int j=0;j<3;++j){ int tr0=q0-128+64*j; if(tr0<0)tr0=0;
    glds16(Kh+(long)(tr0+lane)*PQ+wid*8,(unsigned)__builtin_amdgcn_readfirstlane(lds_set+LDS_K+j*SLOTB+wid*1024));
    glds16(Vh+(long)(tr0+16*(wid&3)+(lane>>2))*PQ+(wid>>2)*32+(lane&3)*8,(unsigned)__builtin_amdgcn_readfirstlane(lds_set+LDS_V+j*SLOTB+wid*1024)); }
}
__device__ __forceinline__ float swa_max3(float a,float b,float c){ float r; asm("v_max3_f32 %0, %1, %2, %3":"=v"(r):"v"(a),"v"(b),"v"(c)); return r; }
__device__ __forceinline__ void swa_unit(int u,int unext,int set,const bf16*Y,const float*__restrict__ sinks,bf16*O,char*shm,const int wv){
  int tid_=wv*64+lane_id_fresh(); const int tid=tid_,lane=tid&63,r32=lane&31,hi=lane>>5; const int wid=__builtin_amdgcn_readfirstlane(tid>>6);
  constexpr int PQ=2560;
  const int q0=(u%(SEQ/64))*64, hk=(u/(SEQ/64))&3, b=u/(4*(SEQ/64));
  const long rowbase=(long)b*SEQ;
  const unsigned lds0=(unsigned)(uintptr_t)shm;
  float*wsf=(float*)(shm+SWA_WS)+wid*64;
  const int qh=hk*8+wid;
  const float sink2=sinks[qh]*1.4426950408889634f;
  bf16x8 qr[4],qn[4];
  { const bf16*Qw=Y+(rowbase+q0)*PQ+qh*64;
    #pragma unroll
    for(int d0=0;d0<4;++d0){qr[d0]=*reinterpret_cast<const bf16x8*>(&Qw[(long)r32*PQ+d0*16+hi*8]);qn[d0]=*reinterpret_cast<const bf16x8*>(&Qw[(long)(32+r32)*PQ+d0*16+hi*8]);} }
  asm volatile("s_waitcnt vmcnt(0) lgkmcnt(0)\n\ts_barrier":::"memory");
  if(unext>=0) swa_issue(unext,Y,lds0+(set^1)*SWA_SET,lane,wid);
  const char*Kbase=shm+set*SWA_SET+LDS_K;
  const int vb0=(int)(lds0+set*SWA_SET+LDS_V)+((lane>>4)&1)*32+(lane&3)*8+(4*hi+((lane&15)>>2))*64;
  const float NEG=-INFINITY;
  const bool fast=(q0>=128);
  f32x16 MC,MO;
  #pragma unroll
  for(int r=0;r<16;++r){ const bool c=((r&3)+8*(r>>2)+4*hi)<=r32; MC[r]=c?0.f:NEG; MO[r]=c?NEG:0.f; }
  #pragma unroll 1
  for(int sb=0;sb<2;++sb){
    const int t=q0+32*sb+r32;
    f32x16 p[3][2];
    #define DEAD(j,x) (((j)==2&&(x)==1&&sb==0)||((j)==0&&(x)==0&&sb==1))
    #pragma unroll
    for(int j=0;j<3;++j){ const char*kb_=Kbase+j*SLOTB+hi*1024+r32*16;
      #pragma unroll
      for(int x=0;x<2;++x){ p[j][x]=f32x16{}; if(DEAD(j,x))continue;
        const bf16x8 k0_=*reinterpret_cast<const bf16x8*>(kb_+x*512);
        if(fast&&j==2&&x==sb) p[j][x]=__builtin_amdgcn_mfma_f32_32x32x16_bf16(k0_,qr[0],MC,0,0,0);
        else if(fast&&j==0&&x==sb) p[j][x]=__builtin_amdgcn_mfma_f32_32x32x16_bf16(k0_,qr[0],MO,0,0,0);
        else p[j][x]=__builtin_amdgcn_mfma_f32_32x32x16_bf16(k0_,qr[0],p[j][x],0,0,0);
        #pragma unroll
        for(int d0=1;d0<4;++d0) p[j][x]=__builtin_amdgcn_mfma_f32_32x32x16_bf16(*reinterpret_cast<const bf16x8*>(kb_+d0*2048+x*512),qr[d0],p[j][x],0,0,0); } }
    #pragma unroll
    for(int d0=0;d0<4;++d0)qr[d0]=qn[d0];
    SBAR(); asm volatile("s_nop 15\n\ts_nop 7"); SBAR();
    float m=sink2;
    const int lo=(t>127)?t-127:0;
    #pragma unroll
    for(int j=0;j<3;++j){ const int kb=q0-128+64*j+4*hi; const int dlim=(j<2)?lo-kb:t-kb;
      #pragma unroll
      for(int x=0;x<2;++x){ if(DEAD(j,x))continue;
        if(fast||(j==1&&q0>=64)){
          #pragma unroll
          for(int r=0;r<16;r+=2) m=swa_max3(m,p[j][x][r],p[j][x][r+1]);
          continue; }
        #pragma unroll
        for(int r=0;r<16;++r){ const int kr=(r&3)+8*(r>>2)+32*x; const bool ok=(j<2)?(kr>=dlim):(kr<=dlim); const float v=ok?p[j][x][r]:NEG; p[j][x][r]=v; if(r&1) m=swa_max3(m,p[j][x][r-1],v); } } }
    { auto rr=__builtin_amdgcn_permlane32_swap(__float_as_uint(m),__float_as_uint(m),false,false); m=__builtin_fmaxf(__uint_as_float(rr[0]),__uint_as_float(rr[1])); }
    float l;
    { typedef float f32x2 __attribute__((ext_vector_type(2)));
      f32x2 l2={0.f,0.f}; const f32x2 M2={m,m};
      #pragma unroll
      for(int j=0;j<3;++j)
        #pragma unroll
        for(int x=0;x<2;++x){ if(DEAD(j,x))continue;
          #pragma unroll
          for(int r=0;r<16;r+=2){ f32x2 X0=(f32x2){p[j][x][r],p[j][x][r+1]}-M2;
            X0=(f32x2){__builtin_amdgcn_exp2f(X0.x),__builtin_amdgcn_exp2f(X0.y)}; p[j][x][r]=X0.x; p[j][x][r+1]=X0.y; l2+=X0; } }
      l=l2.x+l2.y; }
    { auto rr=__builtin_amdgcn_permlane32_swap(__float_as_uint(l),__float_as_uint(l),false,false); l=__uint_as_float(rr[0])+__uint_as_float(rr[1]); }
    l+=__builtin_amdgcn_exp2f(sink2-m);
    f32x16 o[2]; o[0]=f32x16{}; o[1]=f32x16{};
    #pragma unroll
    for(int j=0;j<3;++j){
      #pragma unroll
      for(int x=0;x<2;++x){ if(DEAD(j,x))continue;
        u32x4 pwa,pwb;
        pwa=(u32x4){cvtpk_s(p[j][x][0],p[j][x][1]),cvtpk_s(p[j][x][2],p[j][x][3]),cvtpk_s(p[j][x][4],p[j][x][5]),cvtpk_s(p[j][x][6],p[j][x][7])};
        pwb=(u32x4){cvtpk_s(p[j][x][8],p[j][x][9]),cvtpk_s(p[j][x][10],p[j][x][11]),cvtpk_s(p[j][x][12],p[j][x][13]),cvtpk_s(p[j][x][14],p[j][x][15])};
        SBAR(); pv2(o,vb0+j*SLOTB,2*x,__builtin_bit_cast(bf16x8,pwa),__builtin_bit_cast(bf16x8,pwb)); } }
    #undef DEAD
    if(hi==0)wsf[32+r32]=__builtin_amdgcn_rcpf(l); asm volatile("s_waitcnt lgkmcnt(0)":::"memory");
    float rli[16];
    #pragma unroll
    for(int r=0;r<16;++r)rli[r]=wsf[32+crow(r,hi)];
    bf16*Ow=O+(rowbase+q0+32*sb)*DMO+qh*64;
    { bf16*stg=(bf16*)(shm+SWA_OST)+wid*2048;
      #pragma unroll
      for(int r=0;r<16;++r){const int orow=crow(r,hi);
        #pragma unroll
        for(int d0=0;d0<2;++d0)stg[orow*64+d0*32+r32]=__float2bfloat16(o[d0][r]*rli[r]);}
      asm volatile("s_waitcnt lgkmcnt(0)":::"memory");
      #pragma unroll
      for(int i=0;i<4;++i){const int row=i*8+(lane>>3),ch=lane&7; const u32x4 v=*(const u32x4*)(stg+row*64+ch*8); *(u32x4*)(Ow+(long)row*DMO+ch*8)=v;}
      asm volatile("s_waitcnt lgkmcnt(0)":::"memory"); }
  }
}
__device__ __forceinline__ void swa_phase(char*lds,const bf16*Y,const float*sinks,bf16*O,int vcu,int G,const int wv){
  constexpr int NU=BATCH*4*(SEQ/64);
  if(vcu<NU){ const int lane=lane_id_fresh(); swa_issue(vcu,Y,(unsigned)(uintptr_t)lds,lane,wv); }
  int set=0;
  for(int u=vcu;u<NU;u+=G,set^=1) swa_unit(u,(u+G<NU)?u+G:-1,set,Y,sinks,O,lds,wv);
  asm volatile("s_waitcnt vmcnt(0) lgkmcnt(0)\n\ts_barrier":::"memory");
}
#undef SBAR
#undef WAIT_BAR
}
namespace mls {
typedef unsigned short bf16_t;
typedef short bf16x8 __attribute__((ext_vector_type(8)));
typedef float f32x4 __attribute__((ext_vector_type(4)));
typedef unsigned u32x4 __attribute__((ext_vector_type(4)));
typedef unsigned u32x2 __attribute__((ext_vector_type(2)));
#define MLAS __attribute__((address_space(3)))
constexpr int SEQ = 8192, NH = 4, DK = 256, DV = 512, L = 64, NC = SEQ / L, YLD = 6144;
constexpr int QF_CH = 4 * 8 * 512, KF_CH = 16 * 2 * 512, VF_CH = 32 * 2 * 512, AF_CH = 4 * 2 * 512;
constexpr int PITCH = 264;
__device__ __forceinline__ float blo(unsigned u) { return __uint_as_float(u << 16); }
__device__ __forceinline__ float bhi(unsigned u) { return __uint_as_float(u & 0xffff0000u); }
__device__ __forceinline__ unsigned pkbf(float lo, float hi) { typedef float f2 __attribute__((ext_vector_type(2))); typedef __bf16 b2 __attribute__((ext_vector_type(2))); f2 v = {lo, hi}; b2 b = __builtin_convertvector(v, b2); return __builtin_bit_cast(unsigned, b); }
__device__ __forceinline__ void glds16(const void* gsrc, unsigned lds_dst) { unsigned keep;
    asm volatile("s_mov_b32 %0, m0\n\ts_mov_b32 m0, %2\n\ts_nop 0\n\tglobal_load_lds_dwordx4 %1, off\n\ts_mov_b32 m0, %0" : "=&s"(keep) : "v"(gsrc), "s"(lds_dst) : "memory"); }

__device__ __forceinline__ void glds16s(const void* sbase, unsigned voff, unsigned lds_dst) { unsigned keep;
    asm volatile("s_mov_b32 %0, m0\n\ts_mov_b32 m0, %3\n\ts_nop 0\n\tglobal_load_lds_dwordx4 %1, %2\n\ts_mov_b32 m0, %0" : "=&s"(keep) : "v"(voff), "s"(sbase), "s"(lds_dst) : "memory"); }

template <class T> __device__ __forceinline__ __attribute__((address_space(1))) T* uniform_ptr(T* p) { const unsigned long long a = (unsigned long long)(uintptr_t)p; unsigned lo = (unsigned)__builtin_amdgcn_readfirstlane((int)(unsigned)a), hi = (unsigned)__builtin_amdgcn_readfirstlane((int)(unsigned)(a >> 32));
    asm volatile("s_nop 4" : "+s"(lo), "+s"(hi));
    return (__attribute__((address_space(1))) T*)(((unsigned long long)hi << 32) | lo); }

typedef short v4i16_t __attribute__((ext_vector_type(4)));
__device__ __forceinline__ u32x4 tr_frag(const MLAS bf16_t* T, int s0, int c0, int lane) {
    const int j = lane & 15, q = j >> 2, p = j & 3;
    const MLAS bf16_t* a0 = T + (s0 + q) * PITCH + c0 + 4 * p;
    const v4i16_t lo = __builtin_amdgcn_ds_read_tr16_b64_v4i16((MLAS v4i16_t*)a0), hi = __builtin_amdgcn_ds_read_tr16_b64_v4i16((MLAS v4i16_t*)(a0 + 4 * PITCH));
    typedef short s8 __attribute__((ext_vector_type(8))); const s8 r = {lo[0], lo[1], lo[2], lo[3], hi[0], hi[1], hi[2], hi[3]};
    return __builtin_bit_cast(u32x4, r);
}
__device__ __forceinline__ void m1_phase(MLAS unsigned char* lds, const bf16_t* Y, const float* GI, const float* LF, bf16_t* QF, bf16_t* KF, bf16_t* VF, bf16_t* AF, float* EG, int vcu, int G, const int wvi) {
    int tid_ = wvi * 64 + lane_id_fresh(); const int tid = tid_, lane = tid & 63, r = lane & 15, g = lane >> 4; const int wid = __builtin_amdgcn_readfirstlane(tid >> 6);
    MLAS bf16_t* B0 = (MLAS bf16_t*)lds; MLAS bf16_t* B1 = B0 + 64 * PITCH; MLAS bf16_t* B2 = B1 + 64 * PITCH; MLAS bf16_t* AM = B2 + 64 * PITCH;
    MLAS float* bv = (MLAS float*)(AM + 64 * 72); MLAS float* wl = bv + 64; MLAS float* wv = wl + 64; MLAS float* eb = wv + 64;
    for (int ch = vcu; ch < 2 * NH * NC; ch += G) {
        const int c = ch % NC, h = (ch / NC) % NH, b = ch / (NC * NH);
        const size_t row0 = (size_t)b * SEQ + (size_t)c * L;
        __syncthreads();
        for (int i = tid; i < 64 * 32; i += 512) { const int rr = i >> 5, cc = i & 31; const bf16_t* src = Y + (row0 + rr) * YLD + h * DK + cc * 8;
            *(MLAS u32x4*)(B0 + rr * PITCH + cc * 8) = *(const u32x4*)src; *(MLAS u32x4*)(B1 + rr * PITCH + cc * 8) = *(const u32x4*)(src + 1024);
            *(MLAS u32x4*)(B2 + rr * PITCH + cc * 8) = *(const u32x4*)(Y + (row0 + rr) * YLD + 2048 + h * DV + cc * 8); }
        if (wid == 0) { const float lf = LF[(row0 + lane) * 4 + h], gi = GI[(row0 + lane) * 4 + h];
            float inc = lf;
#pragma unroll
            for (int o = 1; o < 64; o <<= 1) { const float y = __int_as_float(__builtin_amdgcn_ds_bpermute((lane - o) << 2, __float_as_int(inc))); if (lane >= o) inc += y; }
            const float gt = __int_as_float(__builtin_amdgcn_ds_bpermute(63 << 2, __float_as_int(inc)));
            bv[lane] = inc; wl[lane] = gi - inc; wv[lane] = __expf(gt + gi - inc); eb[lane] = __expf(inc);
            if (lane == 0) EG[ch] = __expf(gt); }
        __syncthreads();
        { const int tt = wid >> 1;
#pragma unroll
          for (int jj = 0; jj < 2; ++jj) { const int st = 2 * (wid & 1) + jj; f32x4 acc = {0.f, 0.f, 0.f, 0.f};
            if (st <= tt) { bf16x8 X[8], Yf[8];
#pragma unroll
                for (int ks = 0; ks < 8; ++ks) { X[ks] = *(const MLAS bf16x8*)(B0 + (16 * tt + r) * PITCH + 32 * ks + 8 * g); Yf[ks] = *(const MLAS bf16x8*)(B1 + (16 * st + r) * PITCH + 32 * ks + 8 * g); }
                __builtin_amdgcn_sched_barrier(0);
#pragma unroll
                for (int ks = 0; ks < 8; ++ks) acc = __builtin_amdgcn_mfma_f32_16x16x32_bf16(X[ks], Yf[ks], acc, 0, 0, 0); }
            const int s = 16 * st + r; const float wls = wl[s];
#pragma unroll
            for (int i = 0; i < 4; ++i) { const int t = 16 * tt + 4 * g + i; const float val = (s <= t) ? __expf(bv[t] + wls) * acc[i] : 0.f; AM[t * 72 + s] = (bf16_t)(pkbf(val, 0.f) & 0xffffu); } } }
#pragma unroll
        for (int f4 = 0; f4 < 4; ++f4) { const int f = wid * 4 + f4, tt = f >> 3, ks = f & 7, t = 16 * tt + r; const float e = eb[t];
            const u32x2 lo = *(const MLAS u32x2*)(B0 + t * PITCH + 32 * ks + 4 * g), hi = *(const MLAS u32x2*)(B0 + t * PITCH + 32 * ks + 16 + 4 * g);
            u32x4 o; o.x = pkbf(blo(lo.x) * e, bhi(lo.x) * e); o.y = pkbf(blo(lo.y) * e, bhi(lo.y) * e); o.z = pkbf(blo(hi.x) * e, bhi(hi.x) * e); o.w = pkbf(blo(hi.y) * e, bhi(hi.y) * e);
            *(u32x4*)(QF + (size_t)ch * QF_CH + (size_t)f * 512 + lane * 8) = o; }
        __syncthreads();
        for (int i = tid; i < 64 * 32; i += 512) { const int rr = i >> 5, cc = i & 31; const float w = wv[rr]; const u32x4 kx = *(const MLAS u32x4*)(B1 + rr * PITCH + cc * 8);
            u32x4 o; o.x = pkbf(blo(kx.x) * w, bhi(kx.x) * w); o.y = pkbf(blo(kx.y) * w, bhi(kx.y) * w); o.z = pkbf(blo(kx.z) * w, bhi(kx.z) * w); o.w = pkbf(blo(kx.w) * w, bhi(kx.w) * w);
            *(MLAS u32x4*)(B1 + rr * PITCH + cc * 8) = o;
            *(MLAS u32x4*)(B0 + rr * PITCH + cc * 8) = *(const u32x4*)(Y + (row0 + rr) * YLD + 2048 + h * DV + 256 + cc * 8); }
        { const int tt = wid >> 1, ks = wid & 1; *(u32x4*)(AF + (size_t)ch * AF_CH + (size_t)wid * 512 + lane * 8) = *(const MLAS u32x4*)(AM + (16 * tt + r) * 72 + 32 * ks + 8 * g); }
        __syncthreads();
#pragma unroll
        for (int f4 = 0; f4 < 4; ++f4) { const int f = wid * 4 + f4, dt = f >> 1, ks = f & 1;
            *(u32x4*)(KF + (size_t)ch * KF_CH + (size_t)f * 512 + lane * 8) = tr_frag(B1, 32 * ks + 8 * g, 16 * dt, lane); }
#pragma unroll
        for (int f8 = 0; f8 < 8; ++f8) { const int f = wid * 8 + f8, et = f >> 1, ks = f & 1; const MLAS bf16_t* Bv = (et >= 16) ? B0 : B2;
            *(u32x4*)(VF + (size_t)ch * VF_CH + (size_t)f * 512 + lane * 8) = tr_frag(Bv, 32 * ks + 8 * g, (16 * et) & 255, lane); }
    }
}

constexpr int BUF_BYTES = (QF_CH + KF_CH + AF_CH) * 2;
constexpr int M2_DEN_OFF = 2 * BUF_BYTES, M2_LDS_BYTES = M2_DEN_OFF + 1024;
constexpr int NSEG = 4, SEGC = NC / NSEG;
template <int PASS>
__device__ __forceinline__ void m2_phase(MLAS unsigned char* lds, char* lds_generic, const bf16_t* Y, const bf16_t* QF, const bf16_t* KF, const bf16_t* VF, const bf16_t* AF, const float* EG, float* CST, float* DSEG, bf16_t* AO, int bx, int G, const int wvi) {
    int tid_ = wvi * 64 + lane_id_fresh(); const int tid = tid_, lane = tid & 63, r = lane & 15, g = lane >> 4; const int wid = __builtin_amdgcn_readfirstlane(tid >> 6);
    const unsigned lds0 = (unsigned)(uintptr_t)lds_generic;
    MLAS float* DEN = (MLAS float*)(lds + M2_DEN_OFF);
    for (int u_ = bx; u_ < 64 * NSEG; u_ += G) { const int u = __builtin_amdgcn_readfirstlane(u_);
        const int bh = u & 7, sl = (u >> 3) & 7, seg = u >> 6, b = bh >> 2, h = bh & 3;
        if (PASS == 0 && seg == NSEG - 1) continue;
        const size_t ch0 = (size_t)bh * NC; const size_t rowb = (size_t)b * SEQ;
        const int et = 4 * sl + wid;
        const int ecol = h * DV + 16 * et + r;
        const int c0 = seg * SEGC;
        f32x4 C[16];
#pragma unroll
        for (int i = 0; i < 16; ++i) C[i] = (f32x4){0.f, 0.f, 0.f, 0.f};
        if (PASS == 1 && seg > 0 && wid < 5) {
            unsigned l_ = (unsigned)lane; asm volatile("" : "+v"(l_));
            const f32x4* c0p = (const f32x4*)CST + ((((size_t)(bh * (NSEG - 1) + 0) * 8 + sl) * 5 + wid) * 16) * 64 + l_;
            const size_t sstr = (size_t)8 * 5 * 16 * 64;
#pragma unroll
            for (int i = 0; i < 16; ++i) C[i] = c0p[(size_t)i * 64];
            if (seg > 1) { const float d1 = DSEG[bh * NSEG + 1];
#pragma unroll
                for (int i = 0; i < 16; ++i) C[i] = C[i] * d1 + c0p[sstr + (size_t)i * 64]; }
            if (seg > 2) { const float d2 = DSEG[bh * NSEG + 2];
#pragma unroll
                for (int i = 0; i < 16; ++i) C[i] = C[i] * d2 + c0p[2 * sstr + (size_t)i * 64]; }
        }
#define M2_DMA(cc, buf) do { const unsigned base_ = lds0 + (buf) * BUF_BYTES; const size_t chx_ = ch0 + (cc); \
            if (PASS == 1) { _Pragma("unroll") for (int p_ = 0; p_ < 9; ++p_) { const int pc_ = wid * 9 + p_; const bf16_t* src_ = (pc_ < 32) ? QF + chx_ * QF_CH + (size_t)pc_ * 512 : (pc_ < 64) ? KF + chx_ * KF_CH + (size_t)(pc_ - 32) * 512 : AF + chx_ * AF_CH + (size_t)(pc_ - 64) * 512; \
                glds16(src_ + lane * 8, (unsigned)__builtin_amdgcn_readfirstlane(base_ + pc_ * 1024)); } } \
            else { _Pragma("unroll") for (int p_ = 0; p_ < 4; ++p_) { const int pc_ = 32 + wid * 4 + p_; glds16(KF + chx_ * KF_CH + (size_t)(pc_ - 32) * 512 + lane * 8, (unsigned)__builtin_amdgcn_readfirstlane(base_ + pc_ * 1024)); } } } while (0)
        __syncthreads();
        M2_DMA(c0, 0);
        bf16x8 vf[2], vfn[2];
        unsigned o1_ = 0x3F803F80u; asm volatile("" : "+v"(o1_));
        const bf16x8 ones = __builtin_bit_cast(bf16x8, (u32x4){o1_, o1_, o1_, o1_});
        if (wid < 4) { vf[0] = *(const bf16x8*)(VF + (ch0 + c0) * VF_CH + (size_t)(et * 2 + 0) * 512 + lane * 8); vf[1] = *(const bf16x8*)(VF + (ch0 + c0) * VF_CH + (size_t)(et * 2 + 1) * 512 + lane * 8); }
        else { vf[0] = ones; vf[1] = ones; }
        vfn[0] = vf[0]; vfn[1] = vf[1];
        float dprod = 1.f;
        unsigned ogoff = (unsigned)((4 * g * YLD + r) * 2), aooff = (unsigned)(4 * g * 2048 + r);
        asm volatile("" : "+v"(ogoff), "+v"(aooff));
        MLAS float* egl = DEN + 128;
        { unsigned t_ = (unsigned)tid; asm volatile("" : "+v"(t_)); if (t_ < (unsigned)SEGC) egl[t_] = EG[ch0 + c0 + t_]; }
        asm volatile("s_waitcnt vmcnt(0) lgkmcnt(0)\n\ts_barrier" ::: "memory");
        for (int ci = 0; ci < SEGC; ++ci) {
            const int c = c0 + ci, buf = ci & 1;
            if (ci + 1 < SEGC) { M2_DMA(c + 1, buf ^ 1);
                if (wid < 4) { const bf16_t* v0_ = VF + (ch0 + c + 1) * VF_CH + (size_t)(et * 2 + 0) * 512 + lane * 8;
                    asm volatile("global_load_dwordx4 %0, %2, off\n\tglobal_load_dwordx4 %1, %2, off offset:1024" : "=&v"(vfn[0]), "=&v"(vfn[1]) : "v"(v0_) : "memory"); } }
            const size_t row0 = rowb + (size_t)c * L;
            __attribute__((address_space(1))) bf16_t* aob = uniform_ptr(AO + row0 * 2048 + h * DV + 16 * et);
            const __attribute__((address_space(1))) bf16_t* ogb = uniform_ptr(Y + row0 * YLD + 4096 + h * DV + 16 * et);
            f32x4 num[4];
            unsigned og[16];
            if (wid < 5) {
                const MLAS unsigned char* qb = lds + buf * BUF_BYTES; const MLAS unsigned char* kb = qb + QF_CH * 2; const MLAS unsigned char* ab = kb + KF_CH * 2;
                const float eg = egl[ci];
                if (PASS == 1) {
                    if (wid < 4) {
#pragma unroll
                        for (int tt = 0; tt < 4; ++tt)
#pragma unroll
                            for (int i = 0; i < 4; ++i) { const __attribute__((address_space(1))) bf16_t* sb_ = ogb + (16 * tt + i) * YLD; asm volatile("global_load_ushort %0, %1, %2" : "=v"(og[tt * 4 + i]) : "v"(ogoff), "s"(sb_) : "memory"); }
                    }
                    bf16x8 yc[8];
#pragma unroll
                    for (int ks = 0; ks < 8; ++ks) { u32x4 w; w.x = pkbf(C[2 * ks][0], C[2 * ks][1]); w.y = pkbf(C[2 * ks][2], C[2 * ks][3]); w.z = pkbf(C[2 * ks + 1][0], C[2 * ks + 1][1]); w.w = pkbf(C[2 * ks + 1][2], C[2 * ks + 1][3]); yc[ks] = __builtin_bit_cast(bf16x8, w); }
                    bf16x8 fA[10], fB[10];
#define M2_LD10(dst, tt_) do { _Pragma("unroll") for (int ks = 0; ks < 8; ++ks) dst[ks] = *(const MLAS bf16x8*)(qb + ((tt_) * 8 + ks) * 1024 + lane * 16); \
                        dst[8] = *(const MLAS bf16x8*)(ab + ((tt_) * 2 + 0) * 1024 + lane * 16); dst[9] = *(const MLAS bf16x8*)(ab + ((tt_) * 2 + 1) * 1024 + lane * 16); } while (0)
#define M2_MM10(src, tt_) do { f32x4 a = {0.f, 0.f, 0.f, 0.f}; _Pragma("unroll") for (int ks = 0; ks < 8; ++ks) a = __builtin_amdgcn_mfma_f32_16x16x32_bf16(src[ks], yc[ks], a, 0, 0, 0); \
                        a = __builtin_amdgcn_mfma_f32_16x16x32_bf16(src[8], vf[0], a, 0, 0, 0); a = __builtin_amdgcn_mfma_f32_16x16x32_bf16(src[9], vf[1], a, 0, 0, 0); num[tt_] = a; } while (0)
                    M2_LD10(fA, 0); __builtin_amdgcn_sched_barrier(0);
                    M2_LD10(fB, 1); __builtin_amdgcn_sched_barrier(0); M2_MM10(fA, 0); __builtin_amdgcn_sched_barrier(0);
                    M2_LD10(fA, 2); __builtin_amdgcn_sched_barrier(0); M2_MM10(fB, 1); __builtin_amdgcn_sched_barrier(0);
                    M2_LD10(fB, 3); __builtin_amdgcn_sched_barrier(0); M2_MM10(fA, 2); __builtin_amdgcn_sched_barrier(0);
                    M2_MM10(fB, 3); __builtin_amdgcn_sched_barrier(0);
#undef M2_LD10
#undef M2_MM10
                    if (wid == 4 && r == 0) {
#pragma unroll
                        for (int tt = 0; tt < 4; ++tt)
#pragma unroll
                            for (int i = 0; i < 4; ++i) DEN[buf * 64 + 16 * tt + 4 * g + i] = num[tt][i];
                    }
                } else dprod *= eg;
                {
                    bf16x8 kA[8], kB[8];
#define M2_LDK(dst, q_) do { _Pragma("unroll") for (int i_ = 0; i_ < 8; ++i_) dst[i_] = *(const MLAS bf16x8*)(kb + ((q_) * 8 + i_) * 1024 + lane * 16); } while (0)
#define M2_MMK(src, q_) do { _Pragma("unroll") for (int d_ = 0; d_ < 4; ++d_) { f32x4 a = C[(q_) * 4 + d_] * eg; a = __builtin_amdgcn_mfma_f32_16x16x32_bf16(src[2 * d_], vf[0], a, 0, 0, 0); a = __builtin_amdgcn_mfma_f32_16x16x32_bf16(src[2 * d_ + 1], vf[1], a, 0, 0, 0); C[(q_) * 4 + d_] = a; } } while (0)
                    M2_LDK(kA, 0); __builtin_amdgcn_sched_barrier(0);
                    M2_LDK(kB, 1); __builtin_amdgcn_sched_barrier(0); M2_MMK(kA, 0); __builtin_amdgcn_sched_barrier(0);
                    M2_LDK(kA, 2); __builtin_amdgcn_sched_barrier(0); M2_MMK(kB, 1); __builtin_amdgcn_sched_barrier(0);
                    M2_LDK(kB, 3); __builtin_amdgcn_sched_barrier(0); M2_MMK(kA, 2); __builtin_amdgcn_sched_barrier(0);
                    M2_MMK(kB, 3); __builtin_amdgcn_sched_barrier(0);
#undef M2_LDK
#undef M2_MMK
                }
            }
            if (PASS == 1 && wid < 4) asm volatile("" : "+v"(og[0]), "+v"(og[1]), "+v"(og[2]), "+v"(og[3]), "+v"(og[4]), "+v"(og[5]), "+v"(og[6]), "+v"(og[7]), "+v"(og[8]), "+v"(og[9]), "+v"(og[10]), "+v"(og[11]), "+v"(og[12]), "+v"(og[13]), "+v"(og[14]), "+v"(og[15]));
            asm volatile("s_waitcnt vmcnt(0) lgkmcnt(0)\n\ts_barrier" : "+v"(vfn[0]), "+v"(vfn[1]) :: "memory");
            __builtin_amdgcn_sched_barrier(0);
            if (PASS == 1 && wid < 4) {
                asm volatile("" : "+v"(aooff));
#pragma unroll
                for (int tt = 0; tt < 4; ++tt) { const f32x4 dn = *(const MLAS f32x4*)(DEN + buf * 64 + 16 * tt + 4 * g);
#pragma unroll
                    for (int i = 0; i < 4; ++i) { const float ov = __uint_as_float((unsigned)og[tt * 4 + i] << 16); const float hv = num[tt][i] * __builtin_amdgcn_rcpf(fmaxf(fabsf(dn[i]), 1.f) * (1.f + __expf(-ov)));
                        aob[aooff + (unsigned)((16 * tt + i) * 2048)] = (bf16_t)(pkbf(hv, 0.f) & 0xffffu); } }
            }
            vf[0] = vfn[0]; vf[1] = vfn[1];
        }
        if (PASS == 0 && wid < 5) {
            f32x4* cp = (f32x4*)CST + ((((size_t)(bh * (NSEG - 1) + seg) * 8 + sl) * 5 + wid) * 16) * 64 + lane;
#pragma unroll
            for (int i = 0; i < 16; ++i) cp[(size_t)i * 64] = C[i];
            if (wid == 0 && lane == 0 && sl == 0) DSEG[bh * NSEG + seg] = dprod;
        }
#undef M2_DMA
    }
}
#undef MLAS
}
struct Frame {
    LAS unsigned char* lds; volatile LAS unsigned* MISC;
    int tid, lane, wave, vcu, G, bx;
};
__device__ __forceinline__ float shx(float v, int mask, int lane) { return __int_as_float(__builtin_amdgcn_ds_bpermute((lane ^ mask) << 2, __float_as_int(v))); }
__device__ __forceinline__ float wave_sum(float v, int lane) {
#pragma unroll
    for (int o = 1; o < 64; o <<= 1) v += shx(v, o, lane);
    return v;
}
__device__ __forceinline__ float bf_lo(unsigned u) { return __uint_as_float(u << 16); }
__device__ __forceinline__ float bf_hi(unsigned u) { return __uint_as_float(u & 0xffff0000u); }
__device__ __forceinline__ float dot8(v4u a, v4u b) {
    float s = bf_lo(a.x) * bf_lo(b.x); s += bf_hi(a.x) * bf_hi(b.x); s += bf_lo(a.y) * bf_lo(b.y); s += bf_hi(a.y) * bf_hi(b.y);
    s += bf_lo(a.z) * bf_lo(b.z); s += bf_hi(a.z) * bf_hi(b.z); s += bf_lo(a.w) * bf_lo(b.w); s += bf_hi(a.w) * bf_hi(b.w); return s;
}
template <int MAP> __device__ __forceinline__ int map_col(int n) {
    if (MAP == 1) { if (n < 2304) { const int hb = n & ~63, d = n & 63; const int p = (d < 32) ? ((d >> 2) * 8 + (d & 3)) : (((d - 32) >> 2) * 8 + 4 + (d & 3)); return hb + p; } return n; }
    if (MAP == 2) { const int hv = (n >= DFF) ? 1 : 0, q = n - hv * DFF; return 256 * (q >> 7) + 128 * hv + (q & 127); }
    return n;
}
template <int MAP, bool FOLD> __device__ __forceinline__ void p0_transpose_item(const float* W, int K, int Nsrc, int Npad, bf16* WT, LAS float* scr, int item, int lane,
                                                                               const float* ng, const float* modp  , unsigned long long* biasp) {
    const int nblk = Npad / 64, kb = item / nblk, nb = item % nblk, k0 = 64 * kb, n0 = 64 * nb;
    { const int n4 = lane & 15, kr = lane >> 4; const int nn = n0 + 4 * n4; const bool ok = nn < Nsrc;
#pragma unroll
      for (int h = 0; h < 2; ++h) { f32x4 v[8];
#pragma unroll
        for (int i = 0; i < 8; ++i) { const int kk = 4 * (8 * h + i) + kr; v[i] = ok ? *(const GAS f32x4*)(W + (size_t)(k0 + kk) * Nsrc + nn) : (f32x4){0.f, 0.f, 0.f, 0.f}; }
#pragma unroll
        for (int i = 0; i < 8; ++i) { const int kk = 4 * (8 * h + i) + kr; LAS float* d = scr + kk * 65 + 4 * n4; d[0] = v[i][0]; d[1] = v[i][1]; d[2] = v[i][2]; d[3] = v[i][3]; } } }
    LDS_WAIT(); asm volatile("" ::: "memory");
    const int c = lane & 7, nr = lane >> 3;
    float gk[2][8], sh[2][8];
    if (FOLD) {
#pragma unroll
        for (int bb = 0; bb < 2; ++bb)
#pragma unroll
            for (int i = 0; i < 8; ++i) { const int k = k0 + 8 * c + i; gk[bb][i] = ng[k] * (1.f + modp[bb * MODN + DM + k]); sh[bb][i] = modp[bb * MODN + k]; }
    }
#pragma unroll
    for (int j = 0; j < 8; ++j) { const int n = nr + 8 * j; const LAS float* s = scr + (8 * c) * 65 + n; float x[8];
#pragma unroll
        for (int i = 0; i < 8; ++i) x[i] = s[i * 65];
        const size_t drow = (size_t)map_col<MAP>(n0 + n);
        if (!FOLD) { v4u o; o.x = pk2(x[0], x[1]); o.y = pk2(x[2], x[3]); o.z = pk2(x[4], x[5]); o.w = pk2(x[6], x[7]); *(GAS v4u*)(WT + drow * K + k0 + 8 * c) = o; }
        else {
#pragma unroll
            for (int bb = 0; bb < 2; ++bb) { v4u o; o.x = pk2(x[0] * gk[bb][0], x[1] * gk[bb][1]); o.y = pk2(x[2] * gk[bb][2], x[3] * gk[bb][3]); o.z = pk2(x[4] * gk[bb][4], x[5] * gk[bb][5]); o.w = pk2(x[6] * gk[bb][6], x[7] * gk[bb][7]);
                *(GAS v4u*)(WT + (size_t)bb * Npad * K + drow * K + k0 + 8 * c) = o;
                float p = 0.f;
#pragma unroll
                for (int i = 0; i < 8; ++i) p += x[i] * sh[bb][i];
                p += shx(p, 1, lane); p += shx(p, 2, lane); p += shx(p, 4, lane);
                if (c == 0 && biasp) atomicAdd(biasp + (size_t)bb * Npad + drow, (unsigned long long)(long long)(p * BIAS_SCALE)); } }
    }
    LDS_WAIT(); asm volatile("" ::: "memory");
}
constexpr int BG_I_O = (DM / 64) * (DM / 64), BG_I_D = (DFF / 64) * (DM / 64), BG_I_U = (DM / 64) * (NUP / 64), BG_I_A = (DM / 64) * (A_IN / 64), BG_I_BC = (DM / 64) * (BC_PAD / 64);
struct Ptrs {
    const float *x, *c; const int* pos; const float *mod_w, *mod_b, *norm_g, *final_g, *a_w_in, *a_sinks, *a_w_out, *b_w_in, *b_f_bias, *b_w_out, *c_w_in, *c_gate_bias, *c_w_out, *w_up, *conv_w, *conv_b, *w_dn;
    float* out; unsigned char* ws;
};
__device__ __forceinline__ void p0a_prologue(Frame& F, const Ptrs& P) {
    unsigned char* ws = P.ws;
    const int gw = F.vcu * NWAVES + F.wave, NGW = F.G * NWAVES;
    {
        LAS float* ca = (LAS float*)(F.lds);
        LAS float* red = ca + 2 * DM;
        for (int i = F.tid; i < 2 * DM; i += 512) { const float v = P.c[i]; ca[i] = v / (1.f + __expf(-v)); }
        __syncthreads();
        const int ks = F.tid / 48, cg = F.tid % 48;
        for (int u = F.vcu; u < NL * (MODN / 192); u += F.G) {
            const int l = u / (MODN / 192), n0 = (u % (MODN / 192)) * 192 + 4 * cg;
            f32x4 a0 = {0.f, 0.f, 0.f, 0.f}, a1 = a0;
            if (ks < 8) { const float* wp = P.mod_w + ((size_t)l * DM + ks * 256) * MODN + n0;
#pragma unroll 8
                for (int k = 0; k < 256; ++k) { const f32x4 w = *(const GAS f32x4*)(wp + (size_t)k * MODN); a0 += w * ca[ks * 256 + k]; a1 += w * ca[DM + ks * 256 + k]; } }
            __syncthreads();
            if (ks < 8) { *(LAS f32x4*)(red + (ks * 48 + cg) * 8) = a0; *(LAS f32x4*)(red + (ks * 48 + cg) * 8 + 4) = a1; }
            __syncthreads();
            if (F.tid < 96) { const int b = F.tid / 48; f32x4 s = *(const GAS f32x4*)(P.mod_b + (size_t)l * MODN + n0);
#pragma unroll
                for (int q = 0; q < 8; ++q) s += *(LAS f32x4*)(red + (q * 48 + cg) * 8 + 4 * b);
                *(GAS f32x4*)((float*)(ws + WS_MODV) + (size_t)(l * 2 + b) * MODN + n0) = s; }
        }
        __syncthreads();
    }
    {
        float* RC = (float*)(ws + WS_RC); float* RS = (float*)(ws + WS_RS);
        for (int i = F.vcu * 512 + F.tid; i < M * 32; i += F.G * 512) { const int m = i >> 5, f = i & 31;
            const float inv = powf(10000.f, -(float)(2 * f) / 64.f); const float ang = (float)P.pos[m] * inv; float sv, cv; sincosf(ang, &sv, &cv); RC[i] = cv; RS[i] = sv; }
    }
    __syncthreads();
}
__host__ __device__ constexpr int bg_lim(int l) { return (l + 1) * (BG_I_O + BG_I_U + BG_I_D) + (l >= 0 ? BG_I_BC : 0) + (l >= 1 ? BG_I_BC : 0) + (l >= 2 ? BG_I_A : 0); }
constexpr int NBG = bg_lim(3);
typedef const __attribute__((address_space(4))) Args* bg_args_t;
__device__ __forceinline__ void bg_item(const Ptrs& P, bg_args_t ap, LAS float* scr, int t, int lane) {
    unsigned char* ws = P.ws; const float* MODV = (const float*)(ws + WS_MODV); unsigned long long* BIAS = (unsigned long long*)(ws + WS_BIAS);
    const int l = (t >= bg_lim(2)) ? 3 : (t >= bg_lim(1)) ? 2 : (t >= bg_lim(0)) ? 1 : 0;
    int r = t - ((l == 3) ? bg_lim(2) : (l == 2) ? bg_lim(1) : (l == 1) ? bg_lim(0) : 0);
    if (r < BG_I_O + BG_I_U + BG_I_D) {
        if (r >= BG_I_O && r < BG_I_O + BG_I_U) { r -= BG_I_O;
            p0_transpose_item<2, true>(P.w_up + (size_t)l * DM * NUP, DM, NUP, NUP, (bf16*)(ws + WS_WUP) + (size_t)l * 2 * NUP * DM, scr, r, lane, P.norm_g + (size_t)(l * 2 + 1) * DM, MODV + (size_t)l * 2 * MODN + 3 * DM, BIAS + BIAS_UP + (size_t)l * 2 * NUP); }
        else { const bool dn = r >= BG_I_O; if (dn) r -= BG_I_O + BG_I_U; const int kind = l % 3, j = l / 3;
            const float* src = dn ? P.w_dn + (size_t)l * DFF * DM : (const float*)ap->in[9 + 3 * kind] + (size_t)j * DM * DM;
            p0_transpose_item<0, false>(src, dn ? DFF : DM, DM, DM, dn ? (bf16*)(ws + WS_WDN) + (size_t)l * DM * DFF : (bf16*)(ws + WS_WOUT) + (size_t)l * DM * DM, scr, r, lane, nullptr, nullptr, nullptr); }
    } else { r -= BG_I_O + BG_I_U + BG_I_D; const int ln = l + 1;
        if (ln == 3) p0_transpose_item<1, true>(P.a_w_in + (size_t)DM * A_IN, DM, A_IN, A_IN, (bf16*)(ws + WS_WAIN) + (size_t)2 * A_IN * DM, scr, r, lane, P.norm_g + (size_t)(3 * 2) * DM, MODV + (size_t)3 * 2 * MODN, BIAS + BIAS_A + (size_t)2 * A_IN);
        else p0_transpose_item<0, true>((const float*)ap->in[10 + 3 * (ln - 1)]  , DM, ln == 1 ? B_IN : C_IN, BC_PAD, (bf16*)(ws + (ln == 1 ? WS_WBIN : WS_WCIN)), scr, r, lane, P.norm_g + (size_t)(ln * 2) * DM, MODV + (size_t)ln * 2 * MODN, BIAS + (ln == 1 ? BIAS_B : BIAS_C)); }
}
#ifndef BG_PER_WAVE0
#define BG_PER_WAVE0 16
#endif
constexpr int BG_N0 = 128 * 7 * BG_PER_WAVE0, BG_N3 = bg_lim(3) - bg_lim(2);
static_assert(BG_N0 <= bg_lim(2) && BG_N3 <= bg_lim(3) - bg_lim(2), "deferred items are taken from the layer's own group: out / up / down (+ next in-projection), all consumed at least one seam after the in-projection's");
struct BgList { int base, n, j, stride; };
__device__ __forceinline__ BgList bg_list(int l, int bx, int G, int wave) {
    BgList L; const int first_idle = 640 % G; const bool on = (l == 0 || l == 3) && bx >= first_idle && wave >= 1;
    L.base = (l == 0) ? 0 : bg_lim(3) - BG_N3; L.n = on ? ((l == 0) ? BG_N0 : BG_N3) : 0; L.stride = (G - first_idle) * 7; L.j = on ? (bx - first_idle) * 7 + wave - 1 : 0; return L;
}
__device__ __forceinline__ void bg_finish(const Ptrs& P, bg_args_t ap, const BgList L, volatile LAS unsigned* st, LAS float* scr, int wave, int lane) {
    for (int idx = L.j + L.stride * (int)st[8 + wave]; idx < L.n; idx += L.stride) bg_item(P, ap, scr, L.base + idx, lane);
    __syncthreads();
}
__device__ __forceinline__ void xcd_barrier_bg(const XcdBarrier& b, const Ptrs& P, bg_args_t ap, const BgList L, LAS float* scr, int wave, int lane) {
    asm volatile("s_waitcnt vmcnt(0)" ::: "memory");
    __syncthreads();
    if (wave == 0) {
      if (lane == 0) {
        unsigned* bar = b.bar;
        __builtin_amdgcn_s_waitcnt(0);
        unsigned nloc = b.st[0], nx = b.st[1];
        if (nloc == 0u) { xcd_barrier_complete(bar, b.x, nloc, nx); b.st[0] = nloc; b.st[1] = nx; }
        const unsigned old = xb_add(&bar[XB_XSUB(b.x)], 1u);
        const unsigned gen = old / nloc;
        if (old + 1u == (gen + 1u) * nloc) {
            __builtin_amdgcn_fence(__ATOMIC_RELEASE, "agent");
            asm volatile("s_waitcnt vmcnt(0)" ::: "memory");
            const unsigned og = xb_add(&bar[XB_TOP], 1u);
            const unsigned tg = og / nx;
            if (og + 1u == (tg + 1u) * nx) xb_add(&bar[XB_TOPGEN], 1u);
            else XB_SPIN(xb_ld(&bar[XB_TOPGEN]) == tg, bar);
            __builtin_amdgcn_fence(__ATOMIC_ACQUIRE, "agent");
            xb_add(&bar[XB_XGEN(b.x)], 1u);
            asm volatile("s_waitcnt vmcnt(0)" ::: "memory");
        } else {
            XB_SPIN(xb_ld(&bar[XB_XGEN(b.x)]) == gen, bar);
            __builtin_amdgcn_fence(__ATOMIC_ACQUIRE, "agent");
            asm volatile("s_waitcnt vmcnt(0)" ::: "memory");
        }
        b.st[2] = 1u;
      }
    } else {
        unsigned n = 0u;
        for (;;) {
            if (b.st[2] != 0u) break;
            const int idx = L.j + L.stride * (int)n;
            if (idx >= L.n) { while (b.st[2] == 0u) __builtin_amdgcn_s_sleep(8); break; }
            bg_item(P, ap, scr, L.base + idx, lane); ++n;
        }
        if (lane == 0) b.st[8 + wave] = n;
    }
    __syncthreads();
    if (wave == 0 && lane == 0) b.st[2] = 0u;
}
__device__ __forceinline__ void p0b_prologue(Frame& F, const Ptrs& P, bg_args_t ap, const bool nobias = false  ) {
    unsigned char* ws = P.ws;
    LAS float* scr = (LAS float*)(F.lds + RING_OFF + F.wave * 17408);
    const int gw = F.vcu * NWAVES + F.wave, NGW = F.G * NWAVES;
    const float* MODV = (const float*)(ws + WS_MODV); unsigned long long* BIAS = nobias ? (unsigned long long*)nullptr : (unsigned long long*)(ws + WS_BIAS);
    constexpr int NP = NBG - BG_N0 - BG_N3;
    for (int it = gw; it < NP + BG_I_A; it += NGW) { const int r = NP + BG_I_A - 1 - it;
        if (r < BG_I_A) p0_transpose_item<1, true>(P.a_w_in, DM, A_IN, A_IN, (bf16*)(ws + WS_WAIN), scr, r, F.lane, P.norm_g, MODV, BIAS ? BIAS + BIAS_A : BIAS);
        else bg_item(P, ap, scr, r - BG_I_A + BG_N0, F.lane); }
    {
        bf16* XB = (bf16*)(ws + WS_HN); unsigned long long* SS0 = (unsigned long long*)(ws + WS_SS);
        for (int m = gw; m < M; m += NGW) {
            const GAS f32x4* xr = (const GAS f32x4*)(P.x + (size_t)m * DM) + F.lane; GAS unsigned long long* o8 = (GAS unsigned long long*)(XB + (size_t)m * DM) + F.lane;
            float s = 0.f;
#pragma unroll
            for (int j = 0; j < 8; ++j) { const f32x4 v = xr[64 * j]; s += (v.x * v.x + v.y * v.y) + (v.z * v.z + v.w * v.w); o8[64 * j] = (unsigned long long)pk2(v.x, v.y) | ((unsigned long long)pk2(v.z, v.w) << 32); }
            s = wave_sum(s, F.lane); if (F.lane == 0) SS0[m] = (unsigned long long)(s * SS_SCALE);
        }
    }
    __syncthreads();
}
__device__ __forceinline__ void final_norm_phase(Frame& F, const bf16* xin, const long long* ss, const float* g, float* out) {
    for (int it = F.vcu * 512 + F.tid; it < M * (DM / 8); it += F.G * 512) { const int m = it / (DM / 8), c8 = it % (DM / 8);
        const float rstd = __builtin_amdgcn_rsqf((float)ss[m] * (SS_INV / DM) + 1e-6f);
        const v4u w = *(const GAS v4u*)(xin + (size_t)it * 8); const f32x4 g0 = *(const GAS f32x4*)(g + 8 * c8), g1 = *(const GAS f32x4*)(g + 8 * c8 + 4);
        const f32x4 v0 = {bf_lo(w.x), bf_hi(w.x), bf_lo(w.y), bf_hi(w.y)}, v1 = {bf_lo(w.z), bf_hi(w.z), bf_lo(w.w), bf_hi(w.w)};
        *(GAS f32x4*)(out + (size_t)it * 8) = (v0 * rstd) * g0; *(GAS f32x4*)(out + (size_t)it * 8 + 4) = (v1 * rstd) * g1; }
}
__device__ __forceinline__ void scan_phase(Frame& F, const float* LF, int NH, float* Ft) {
    LAS float* wt = (LAS float*)(F.lds);
    for (int sq = F.bx; sq < BATCH * NH; sq += F.G) {
        const int b = sq / NH, h = sq % NH;
        const float* src = LF + ((size_t)b * SEQ + F.tid * 16) * NH + h;
        float p[16];
#pragma unroll
        for (int i = 0; i < 16; ++i) p[i] = src[(size_t)i * NH];
#pragma unroll
        for (int i = 1; i < 16; ++i) p[i] += p[i - 1];
        const float tot = p[15]; float inc = tot;
#pragma unroll
        for (int o = 1; o < 64; o <<= 1) { const float y = __int_as_float(__builtin_amdgcn_ds_bpermute((F.lane - o) << 2, __float_as_int(inc))); if (F.lane >= o) inc += y; }
        __syncthreads();
        if (F.lane == 63) wt[F.wave] = inc;
        __syncthreads();
        float off = inc - tot;
#pragma unroll
        for (int w = 0; w < 8; ++w) if (w < F.wave) off += wt[w];
        GAS f32x4* dst = (GAS f32x4*)(Ft + (size_t)sq * SEQ + F.tid * 16);
#pragma unroll
        for (int q = 0; q < 4; ++q) dst[q] = (f32x4){off + p[4 * q], off + p[4 * q + 1], off + p[4 * q + 2], off + p[4 * q + 3]};
    }
}
__device__ __forceinline__ void conv_act_phase(Frame& F, const bf16* U, const float* cw, const float* cb, bf16* ACT) {
    constexpr int CPR = DFF / 8;
    for (int it = F.vcu * 512 + F.tid; it < M * CPR; it += F.G * 512) {
        const int row = it / CPR, col = (it % CPR) * 8, t = row & (SEQ - 1);
        float y[2][8];
#pragma unroll
        for (int hv = 0; hv < 2; ++hv) { const int cc = col + hv * DFF; const bf16* up = U + (size_t)row * NUP + cc;
            const v4u u2 = *(const GAS v4u*)up; v4u u1 = {0u, 0u, 0u, 0u}, u0 = u1;
            if (t >= 1) u1 = *(const GAS v4u*)(up - NUP); if (t >= 2) u0 = *(const GAS v4u*)(up - 2 * NUP);
            const unsigned a2[4] = {u2.x, u2.y, u2.z, u2.w}, a1[4] = {u1.x, u1.y, u1.z, u1.w}, a0[4] = {u0.x, u0.y, u0.z, u0.w};
#pragma unroll
            for (int e = 0; e < 8; ++e) { const float x2 = (e & 1) ? bf_hi(a2[e >> 1]) : bf_lo(a2[e >> 1]), x1 = (e & 1) ? bf_hi(a1[e >> 1]) : bf_lo(a1[e >> 1]), x0 = (e & 1) ? bf_hi(a0[e >> 1]) : bf_lo(a0[e >> 1]);
                y[hv][e] = x0 * cw[cc + e] + x1 * cw[NUP + cc + e] + x2 * cw[2 * NUP + cc + e] + cb[cc + e]; } }
        float a[8];
#pragma unroll
        for (int e = 0; e < 8; ++e) a[e] = y[0][e] / (1.f + __expf(-y[0][e])) * y[1][e];
        v4u o; o.x = pk2(a[0], a[1]); o.y = pk2(a[2], a[3]); o.z = pk2(a[4], a[5]); o.w = pk2(a[6], a[7]);
        *(GAS v4u*)(ACT + (size_t)row * DFF + col) = o;
    }
}

__device__ __forceinline__ void fixup_phase(Frame& F, const float* HU, const float* cw, const float* cb, bf16* ACT) {
    for (int it = F.vcu * 512 + F.tid; it < 64 * DFF; it += F.G * 512) {
        const int pm = it / DFF, j = it % DFF; if ((pm & 31) == 0) continue;
        const int pg = 256 * (j >> 7) + (j & 127);
        float act[2];
        float y0[2], y1[2];
#pragma unroll
        for (int hv = 0; hv < 2; ++hv) { const int pc = pg + 128 * hv, lc = j + hv * DFF;
            const float um2 = HU[(size_t)((pm - 1) * 4 + 2) * NUP + pc], um1 = HU[(size_t)((pm - 1) * 4 + 3) * NUP + pc], u0 = HU[(size_t)(pm * 4 + 0) * NUP + pc], u1 = HU[(size_t)(pm * 4 + 1) * NUP + pc];
            const float w0 = cw[lc], w1 = cw[NUP + lc], w2 = cw[2 * NUP + lc], bb = cb[lc];
            y0[hv] = w0 * um2 + w1 * um1 + w2 * u0 + bb; y1[hv] = w0 * um1 + w1 * u0 + w2 * u1 + bb; }
        act[0] = y0[0] * __builtin_amdgcn_rcpf(1.f + __expf(-y0[0])) * y0[1]; act[1] = y1[0] * __builtin_amdgcn_rcpf(1.f + __expf(-y1[0])) * y1[1];
        ACT[(size_t)(pm * 256) * DFF + j] = (bf16)f2bf(act[0]); ACT[(size_t)(pm * 256 + 1) * DFF + j] = (bf16)f2bf(act[1]);
    }
}
template <int KIND> __device__ __forceinline__ void gate_rows(const bf16* XB, const bf16* Wc  , const long long* ss, const long long* bias  , const float* gbias, float* G0, float* G1, int bx, int G, const int wvi) {
    const int lane = lane_id_fresh(), r = lane & 15, g = lane >> 4, rt = wvi >> 1, ct = wvi & 1;
    if (KIND == 2 && ct == 1) return;
    for (int rb = bx; rb < M / 64; rb += G) {
        const int row0 = rb * 64, b = (row0 >= SEQ) ? 1 : 0;
        const bf16* xr = XB + (size_t)(row0 + 16 * rt + r) * DM + 8 * g;
        const bf16* wr = Wc + ((size_t)b * BC_PAD + 6144 + 16 * ct + r) * DM + 8 * g;
        f32x4 acc = {0.f, 0.f, 0.f, 0.f};
        bf16x8 X[3][8], Yf[3][8];
#define GR_LD(s_, k0_) do { _Pragma("unroll") for (int i = 0; i < 8; ++i) { X[s_][i] = *(const GAS bf16x8*)(xr + (k0_) + 32 * i); Yf[s_][i] = *(const GAS bf16x8*)(wr + (k0_) + 32 * i); } } while (0)
        GR_LD(0, 0); GR_LD(1, 256); GR_LD(2, 512);
#pragma unroll
        for (int k = 0; k < DM / 256; ++k) {
#pragma unroll
            for (int i = 0; i < 8; ++i) acc = __builtin_amdgcn_mfma_f32_16x16x32_bf16(X[k % 3][i], Yf[k % 3][i], acc, 0, 0, 0);
            if (k + 3 < DM / 256) GR_LD(k % 3, (k + 3) * 256); }
#undef GR_LD
        const int col = 16 * ct + r; typedef unsigned u2_ __attribute__((ext_vector_type(2)));
        const u2_ bw = *(const GAS u2_*)(bias + (size_t)b * BC_PAD + 6144 + col); const float bs = pg8::fx2f(bw[0], bw[1]) * BIAS_INV;
#pragma unroll
        for (int i = 0; i < 4; ++i) { const int row = row0 + 16 * rt + 4 * g + i; const u2_ sv = *(const GAS u2_*)(ss + row);
            const float v = acc[i] * __builtin_amdgcn_rsqf(pg8::fx2f(sv[0], sv[1]) * (SS_INV / 2048.f) + 1e-6f) + bs;
            if (KIND == 1) G0[(size_t)row * 32 + col] = pg8::log_sigmoid_f(v + gbias[col]);
            else if (col < 4) G0[(size_t)row * 4 + col] = v + gbias[col];
            else if (col < 8) G1[(size_t)row * 4 + col - 4] = pg8::log_sigmoid_f(v + gbias[col]); }
    }
}
template <int MODE, int DK, int DV>
__device__ __forceinline__ void naive_mixer(Frame& F, const bf16* Y, int ldy, int qoff, int koff, int voff, int ooff, int NH, int GQ, const float* Ft, const float* GI, const float* sinks, bf16* AO) {
    constexpr int QP = DK + 8, DVT = DV / 8, NQT = SEQ / 64;
    LAS bf16* Qs = (LAS bf16*)(F.lds);
    LAS bf16* Ks = Qs + 64 * QP;
    LAS bf16* Vs = Ks + 32 * QP;
    LAS float* Ps = (LAS float*)(Vs + 32 * DV);
    const int tid = F.tid, qi = tid >> 3, j8 = tid & 7;
    const float NEGINF = -__builtin_inff();
    for (int u = F.vcu; u < BATCH * NH * NQT; u += F.G) {
        const int qt = (NQT - 1) - (u % NQT), bh = u / NQT, h = bh % NH, b = bh / NH, hk = h / GQ;
        const int q0 = qt * 64; const size_t rowbase = (size_t)b * SEQ;
        __syncthreads();
        for (int c = tid; c < 64 * DK / 8; c += 512) { const int r = c / (DK / 8), cc = c % (DK / 8); *(LAS v4u*)(Qs + r * QP + cc * 8) = *(const GAS v4u*)(Y + (rowbase + q0 + r) * ldy + qoff + h * DK + cc * 8); }
        float o[DVT];
#pragma unroll
        for (int e = 0; e < DVT; ++e) o[e] = 0.f;
        const int t = q0 + qi;
        float m = (MODE == 0) ? sinks[h] * LOG2E : NEGINF, l = (MODE == 0) ? 1.f : 0.f, ft_t = 0.f;
        const float* Fh = Ft + (size_t)(b * NH + h) * SEQ;
        if (MODE >= 1) ft_t = Fh[t];
        const int kt_hi = (q0 + 63) / 32; int kt_lo = 0; if (MODE == 0) kt_lo = (q0 >= 127 ? q0 - 127 : 0) / 32;
        for (int kt = kt_lo; kt <= kt_hi; ++kt) {
            __syncthreads();
            for (int c = tid; c < 32 * DK / 8; c += 512) { const int r = c / (DK / 8), cc = c % (DK / 8); *(LAS v4u*)(Ks + r * QP + cc * 8) = *(const GAS v4u*)(Y + (rowbase + kt * 32 + r) * ldy + koff + hk * DK + cc * 8); }
            for (int c = tid; c < 32 * DV / 8; c += 512) { const int r = c / (DV / 8), cc = c % (DV / 8); *(LAS v4u*)(Vs + r * DV + cc * 8) = *(const GAS v4u*)(Y + (rowbase + kt * 32 + r) * ldy + voff + hk * DV + cc * 8); }
            __syncthreads();
#pragma unroll
            for (int c4 = 0; c4 < 4; ++c4) {
                const int kk = j8 + 8 * c4, s = kt * 32 + kk;
                float dot = 0.f;
#pragma unroll 4
                for (int d = 0; d < DK; d += 8) dot += dot8(*(LAS v4u*)(Qs + qi * QP + d), *(LAS v4u*)(Ks + kk * QP + d));
                float val;
                if (MODE == 0) val = (s <= t && t - s < 128) ? dot : NEGINF;
                else if (MODE == 1) val = (s <= t) ? dot + (ft_t - Fh[s]) * LOG2E : NEGINF;
                else val = (s <= t) ? __expf(ft_t - Fh[s] + GI[(rowbase + s) * 4 + h]) * dot : 0.f;
                Ps[qi * 33 + kk] = val;
            }
            __syncthreads();
            if (MODE < 2) {
                float tm = NEGINF;
#pragma unroll 8
                for (int kk = 0; kk < 32; ++kk) tm = fmaxf(tm, Ps[qi * 33 + kk]);
                const float mnew = fmaxf(m, tm);
                if (mnew > NEGINF) {
                    const float sc = exp2f(m - mnew); l *= sc;
#pragma unroll
                    for (int e = 0; e < DVT; ++e) o[e] *= sc;
#pragma unroll 1
                    for (int kk = 0; kk < 32; ++kk) { const float p = exp2f(Ps[qi * 33 + kk] - mnew); l += p;
#pragma unroll
                        for (int e8 = 0; e8 < DVT; e8 += 8) { const v4u vv = *(LAS v4u*)(Vs + kk * DV + j8 * DVT + e8);
                            o[e8 + 0] += p * bf_lo(vv.x); o[e8 + 1] += p * bf_hi(vv.x); o[e8 + 2] += p * bf_lo(vv.y); o[e8 + 3] += p * bf_hi(vv.y);
                            o[e8 + 4] += p * bf_lo(vv.z); o[e8 + 5] += p * bf_hi(vv.z); o[e8 + 6] += p * bf_lo(vv.w); o[e8 + 7] += p * bf_hi(vv.w); } }
                    m = mnew;
                }
            } else {
#pragma unroll 1
                for (int kk = 0; kk < 32; ++kk) { const float p = Ps[qi * 33 + kk]; l += p;
#pragma unroll
                    for (int e8 = 0; e8 < DVT; e8 += 8) { const v4u vv = *(LAS v4u*)(Vs + kk * DV + j8 * DVT + e8);
                        o[e8 + 0] += p * bf_lo(vv.x); o[e8 + 1] += p * bf_hi(vv.x); o[e8 + 2] += p * bf_lo(vv.y); o[e8 + 3] += p * bf_hi(vv.y);
                        o[e8 + 4] += p * bf_lo(vv.z); o[e8 + 5] += p * bf_hi(vv.z); o[e8 + 6] += p * bf_lo(vv.w); o[e8 + 7] += p * bf_hi(vv.w); } }
            }
        }
        const float inv = (MODE < 2) ? 1.f / l : 1.f / fmaxf(fabsf(l), 1.f);
        bf16* op = AO + (rowbase + t) * DM + h * DV + j8 * DVT;
#pragma unroll
        for (int e8 = 0; e8 < DVT; e8 += 8) {
            float r[8];
#pragma unroll
            for (int e = 0; e < 8; ++e) r[e] = o[e8 + e] * inv;
            if (MODE == 2) { const v4u og = *(const GAS v4u*)(Y + (rowbase + t) * ldy + ooff + h * DV + j8 * DVT + e8); const unsigned ow[4] = {og.x, og.y, og.z, og.w};
#pragma unroll
                for (int e = 0; e < 8; ++e) { const float ov = (e & 1) ? bf_hi(ow[e >> 1]) : bf_lo(ow[e >> 1]); r[e] *= 1.f / (1.f + __expf(-ov)); } }
            v4u w; w.x = pk2(r[0], r[1]); w.y = pk2(r[2], r[3]); w.z = pk2(r[4], r[5]); w.w = pk2(r[6], r[7]);
            *(GAS v4u*)(op + e8) = w;
        }
    }
}
constexpr int PH_L0 = 2, PH_FINAL = PH_L0 + 10 * NL, PH_END = PH_FINAL + 1;
__global__ void __launch_bounds__(NWAVES * 64, 2) fwd_kernel(Args args_unused) {
    extern __shared__ __attribute__((aligned(16))) unsigned char lds[];
    typedef const __attribute__((address_space(4))) Args* cargs_t;
#define ARGS() ({ cargs_t _a = (cargs_t)__builtin_amdgcn_kernarg_segment_ptr(); asm volatile("" : "+s"(_a)); _a; })
#define INF32(i) ((const float*)ap->in[i])
#define MKFRAME() Frame F; { int t_ = wv_ * 64 + lane_id_fresh(); F.lds = (LAS unsigned char*)lds; F.MISC = (volatile LAS unsigned*)(F.lds + MISC_OFF); F.tid = t_; F.lane = t_ & 63; F.wave = __builtin_amdgcn_readfirstlane(t_ >> 6); \
        F.G = gridDim.x; int bx_ = blockIdx.x; asm volatile("" : "+s"(bx_)); F.bx = bx_; F.vcu = (F.G % 8 == 0) ? (bx_ % 8) * (F.G / 8) + bx_ / 8 : bx_; }
    int lo, hi;
    const int wv_ = __builtin_amdgcn_readfirstlane((int)threadIdx.x >> 6);
    { cargs_t ap = ARGS(); lo = ap->ph_lo; hi = ap->ph_hi;
      for (int u = threadIdx.x; u < (LDS_BYTES - LDSCTL_OFF) / 4; u += NWAVES * 64) ((LAS unsigned*)((LAS unsigned char*)lds + LDSCTL_OFF))[u] = 0u;
      __syncthreads();
      if (hi - lo > 1) (void)xcd_barrier_post((unsigned*)(ap->ws + WS_CTL) + CW_BAR, (volatile LAS unsigned*)((LAS unsigned char*)lds + MISC_OFF) + 8); }
#ifndef USE_NAIVE_MLSTM
#define USE_NAIVE_MLSTM 0
#endif
#ifndef USE_NAIVE_SWA
#define USE_NAIVE_SWA 0
#endif
#ifndef USE_NAIVE_FOX
#define USE_NAIVE_FOX 0
#endif
#ifndef PHMASK
#define PHMASK 0xffff
#endif
#define ON(n) (((PHMASK) >> (n)) & 1)
#define IN(k) (lo <= (k) && (k) < hi)
#ifndef PROBE_REP
#define PROBE_REP 0
#endif
#ifndef PROBE_KIND
#define PROBE_KIND 7
#endif
#define REPS(n, kindv) ((((PROBE_REP) >> (n)) & 1) && (((PROBE_KIND) >> (kindv)) & 1) ? 2 : 1)
#define GRIDBAR() do { cargs_t ap_ = ARGS(); XcdBarrier b_; b_.bar = (unsigned*)(ap_->ws + WS_CTL) + CW_BAR; b_.x = xb_xcc_id(); b_.st = (volatile LAS unsigned*)((LAS unsigned char*)lds + MISC_OFF) + 8; xcd_barrier(b_); } while (0)
#define SEAM(k) do { if (IN((k) + 1)) { cargs_t ap_ = ARGS(); XcdBarrier b_; b_.bar = (unsigned*)(ap_->ws + WS_CTL) + CW_BAR; b_.x = xb_xcc_id(); b_.st = (volatile LAS unsigned*)((LAS unsigned char*)lds + MISC_OFF) + 8; xcd_barrier(b_); } } while (0)

#define LOADP() Ptrs P; P.x = INF32(0); P.c = INF32(1); P.pos = (const int*)ap->in[2]; P.mod_w = INF32(3); P.mod_b = INF32(4); \
        P.norm_g = INF32(5); P.final_g = INF32(6); P.a_w_in = INF32(7); P.a_sinks = INF32(8); P.a_w_out = INF32(9); \
        P.b_w_in = INF32(10); P.b_f_bias = INF32(11); P.b_w_out = INF32(12); P.c_w_in = INF32(13); P.c_gate_bias = INF32(14); \
        P.c_w_out = INF32(15); P.w_up = INF32(16); P.conv_w = INF32(17); P.conv_b = INF32(18); P.w_dn = INF32(19); P.out = ap->out; P.ws = ap->ws;
    if (ON(0) && IN(0)) { for (int rep_ = 0; rep_ < REPS(0, 0); ++rep_) { if (rep_) GRIDBAR(); { MKFRAME(); cargs_t ap = ARGS(); LOADP(); p0a_prologue(F, P); } } SEAM(0); }
    if (ON(0) && IN(1)) { MKFRAME(); cargs_t ap = ARGS(); LOADP(); p0b_prologue(F, P, ap); SEAM(1); }

    for (int l = 0; l < NL; ++l) {
        const int kind = l % 3, j = l / 3, pb = PH_L0 + 10 * l;
#define XIN() ((l == 0) ? INF32(0) : (const float*)ap->out)
#define MODP() ((const float*)(ws + WS_MODV) + (size_t)l * 2 * MODN)
#define SSIN(sub) ((const float*)(ws + WS_SS) + (size_t)(l * 2 + (sub)) * M)
#define SSOUT(idx) ((float*)(ws + WS_SS) + (size_t)(idx) * M)
        if (ON(2) && IN(pb + 1)) { for (int rep_ = 0; rep_ < REPS(2, kind); ++rep_) { if (rep_) GRIDBAR(); { MKFRAME(); cargs_t ap = ARGS(); unsigned char* ws = ap->ws; const bf16* HN = (const bf16*)(ws + WS_HN); bf16* Y = (bf16*)(ws + WS_Y);
            if (kind == 0) { pg8::Gemm g{HN, (const bf16*)(ws + WS_WAIN) + (size_t)j * 2 * A_IN * DM, M, A_IN, DM, (size_t)A_IN * DM}; pg8::StaticOrder S; S.init(M, A_IN, F.G, F.bx);
                pg8::EpiIn<0> E{l, 0};
                pg8::gemm_phase<pg8::EpiIn<0>, pg8::StaticOrder, true, true>(F.lds + RING_OFF, g, S, E, wv_); }
            else if (kind == 1) { pg8::Gemm g{HN, (const bf16*)(ws + WS_WBIN), M, 6144, DM, (size_t)BC_PAD * DM}; pg8::StaticOrder S; S.init(M, 6144, F.G, F.bx);
                pg8::EpiIn<1> E{l, 0};
                pg8::gemm_phase<pg8::EpiIn<1>, pg8::StaticOrder, true, true>(F.lds + RING_OFF, g, S, E, wv_);
                gate_rows<1>(HN, (const bf16*)(ws + WS_WBIN), (const long long*)(ws + WS_SS) + (size_t)(2 * l) * M, (const long long*)(ws + WS_BIAS) + BIAS_B, INF32(11) + (size_t)j * 32, (float*)(ws + WS_LF), nullptr, F.bx, F.G, wv_); }
            else { pg8::Gemm g{HN, (const bf16*)(ws + WS_WCIN), M, 6144, DM, (size_t)BC_PAD * DM}; pg8::StaticOrder S; S.init(M, 6144, F.G, F.bx);
                pg8::EpiIn<2> E{l, 0};
                pg8::gemm_phase<pg8::EpiIn<2>, pg8::StaticOrder, true, true>(F.lds + RING_OFF, g, S, E, wv_);
                gate_rows<2>(HN, (const bf16*)(ws + WS_WCIN), (const long long*)(ws + WS_SS) + (size_t)(2 * l) * M, (const long long*)(ws + WS_BIAS) + BIAS_C, INF32(14) + (size_t)j * 8, (float*)(ws + WS_GI), (float*)(ws + WS_LFC), F.bx, F.G, wv_); }
            } }
            if (IN(pb + 2)) { MKFRAME(); cargs_t ap = ARGS(); LOADP(); XcdBarrier b_; b_.bar = (unsigned*)(ap->ws + WS_CTL) + CW_BAR; b_.x = xb_xcc_id(); b_.st = (volatile LAS unsigned*)((LAS unsigned char*)lds + MISC_OFF) + 8;
                const BgList L = bg_list(l, F.bx, F.G, F.wave);
                xcd_barrier_bg(b_, P, ap, L, (LAS float*)(F.lds + RING_OFF + F.wave * 17408), F.wave, F.lane);
                if (kind == 0) bg_finish(P, ap, L, b_.st, (LAS float*)(F.lds + RING_OFF + F.wave * 17408), F.wave, F.lane); }
        }
        if (ON(3) && IN(pb + 2)) { for (int rep_ = 0; rep_ < REPS(3, kind); ++rep_) { if (rep_) GRIDBAR(); { MKFRAME(); cargs_t ap = ARGS(); unsigned char* ws = ap->ws;
            if (kind == 1) scan_phase(F, (const float*)(ws + WS_LF), 32, (float*)(ws + WS_FT));
            else if (kind == 2) {
#if USE_NAIVE_MLSTM
                scan_phase(F, (const float*)(ws + WS_LFC), 4, (float*)(ws + WS_FTC));
#else
                mls::m1_phase(F.lds + RING_OFF, (const bf16*)(ws + WS_Y), (const float*)(ws + WS_GI), (const float*)(ws + WS_LFC), (bf16*)(ws + WS_QF), (bf16*)(ws + WS_KF), (bf16*)(ws + WS_VF), (bf16*)(ws + WS_AF), (float*)(ws + WS_EG), F.vcu, F.G, wv_);
#endif
            }
            } } if (kind != 0) SEAM(pb + 2);
        }
        if (ON(4) && IN(pb + 3)) { for (int rep_ = 0; rep_ < REPS(4, kind); ++rep_) { if (rep_) GRIDBAR(); { MKFRAME(); cargs_t ap = ARGS(); unsigned char* ws = ap->ws; const bf16* Y = (const bf16*)(ws + WS_Y); bf16* AO = (bf16*)(ws + WS_AO);
            if (kind == 0) {
#if USE_NAIVE_SWA
                naive_mixer<0, 64, 64>(F, Y, A_IN, 0, 2048, 2304, 0, 32, 8, nullptr, nullptr, INF32(8) + (size_t)j * 32, AO);
#else
                fox_body::swa_phase((char*)lds + RING_OFF, (const fox_body::bf16*)Y, INF32(8) + (size_t)j * 32, (fox_body::bf16*)AO, F.vcu, F.G, wv_);
#endif
            }
            else if (kind == 1) {
#if USE_NAIVE_FOX
                naive_mixer<1, 64, 64>(F, Y, YLD, 0, 2048, 4096, 0, 32, 1, (const float*)(ws + WS_FT), nullptr, nullptr, AO);
#else
                static_assert(fox_body::ATTN_LDS_BYTES <= RING_BYTES, "attention LDS");
                const fox_body::AttnTensors AT{(const fox_body::bf16*)Y, (const fox_body::bf16*)(Y + 2048), (const fox_body::bf16*)(Y + 4096), (fox_body::bf16*)AO, (const float*)(ws + WS_FT), (const unsigned*)(ws + WS_QK2), (unsigned*)(ws + WS_CTL) + CW_QUEUE};
                fox_body::attn_phase<8>((char*)lds + RING_OFF, AT, wv_);
#endif
            }
            else {
#if USE_NAIVE_MLSTM
                naive_mixer<2, 256, 512>(F, Y, YLD, 0, 1024, 2048, 4096, 4, 1, (const float*)(ws + WS_FTC), (const float*)(ws + WS_GI), nullptr, AO);
#else
                static_assert(mls::M2_LDS_BYTES <= RING_BYTES, "mLSTM LDS");
                mls::m2_phase<0>(F.lds + RING_OFF, (char*)lds + RING_OFF, Y, (const bf16*)(ws + WS_QF), (const bf16*)(ws + WS_KF), (const bf16*)(ws + WS_VF), (const bf16*)(ws + WS_AF), (const float*)(ws + WS_EG), (float*)(ws + WS_CST), (float*)(ws + WS_EG) + 4096, AO, F.bx, F.G, wv_);
#endif
            }
            } } SEAM(pb + 3);
        }
        if (ON(4) && IN(pb + 4)) { if (kind == 2) { for (int rep_ = 0; rep_ < REPS(6, kind); ++rep_) { if (rep_) GRIDBAR(); MKFRAME(); cargs_t ap = ARGS(); unsigned char* ws = ap->ws;
                mls::m2_phase<1>(F.lds + RING_OFF, (char*)lds + RING_OFF, (const bf16*)(ws + WS_Y), (const bf16*)(ws + WS_QF), (const bf16*)(ws + WS_KF), (const bf16*)(ws + WS_VF), (const bf16*)(ws + WS_AF), (const float*)(ws + WS_EG), (float*)(ws + WS_CST), (float*)(ws + WS_EG) + 4096, (bf16*)(ws + WS_AO), F.bx, F.G, wv_);
                } SEAM(pb + 4); } }
        if (ON(5) && IN(pb + 5)) { for (int rep_ = 0; rep_ < REPS(5, kind); ++rep_) { if (rep_) GRIDBAR(); { MKFRAME(); cargs_t ap = ARGS(); unsigned char* ws = ap->ws;
            pg8::Gemm g{(const bf16*)(ws + WS_AO), (const bf16*)(ws + WS_WOUT) + (size_t)l * DM * DM, M, DM, DM, 0}; pg8::StaticOrder S; S.init(M, DM, F.G, F.bx);
            pg8::EpiRes E{l, 0, 0, (LAS float*)(F.lds + XCH_OFF)};
            pg8::gemm_phase<pg8::EpiRes, pg8::StaticOrder, true, true>(F.lds + RING_OFF, g, S, E, wv_);
            } } SEAM(pb + 5);
        }
        if (ON(7) && IN(pb + 6)) { for (int rep_ = 0; rep_ < REPS(7, kind); ++rep_) { if (rep_) GRIDBAR(); { MKFRAME(); cargs_t ap = ARGS(); unsigned char* ws = ap->ws;
            pg8::Gemm g{(const bf16*)(ws + WS_X1), (const bf16*)(ws + WS_WUP) + (size_t)l * 2 * NUP * DM, M, NUP, DM, (size_t)NUP * DM};     pg8::StaticOrder S; S.init(M, NUP, F.G, F.bx);
            pg8::EpiUp E{l, (LAS float*)(F.lds + XCH_OFF), (LAS float*)(F.lds + XCH_OFF + 8192)};
            pg8::gemm_phase<pg8::EpiUp, pg8::StaticOrder, true, true>(F.lds + RING_OFF, g, S, E, wv_);
            } } SEAM(pb + 6);
        }
        if (ON(8) && IN(pb + 7)) { for (int rep_ = 0; rep_ < REPS(8, kind); ++rep_) { if (rep_) GRIDBAR(); { MKFRAME(); cargs_t ap = ARGS(); unsigned char* ws = ap->ws; fixup_phase(F, (const float*)(ws + WS_HU), INF32(17) + (size_t)l * 3 * NUP, INF32(18) + (size_t)l * NUP, (bf16*)(ws + WS_ACT)); } } SEAM(pb + 7); }
        if (ON(9) && IN(pb + 8)) { for (int rep_ = 0; rep_ < REPS(9, kind); ++rep_) { if (rep_) GRIDBAR(); { MKFRAME(); cargs_t ap = ARGS(); unsigned char* ws = ap->ws;
            pg8::Gemm g{(const bf16*)(ws + WS_ACT), (const bf16*)(ws + WS_WDN) + (size_t)l * DM * DFF, M, DM, DFF, 0}; pg8::StaticOrder S; S.init(M, DM, F.G, F.bx);
            pg8::EpiRes E{l, 1, 0, (LAS float*)(F.lds + XCH_OFF)};
            pg8::gemm_phase<pg8::EpiRes, pg8::StaticOrder, true, true>(F.lds + RING_OFF, g, S, E, wv_);
            } } SEAM(pb + 8);
        }
    }
    if (ON(10) && IN(PH_FINAL)) { MKFRAME(); cargs_t ap = ARGS(); final_norm_phase(F, (const bf16*)(ap->ws + WS_HN), (const long long*)(ap->ws + WS_SS) + (size_t)8 * M, INF32(6), ap->out); }
#undef IN
#undef SEAM
}

#ifndef MK_ONE_LAUNCH
#define MK_ONE_LAUNCH 1
#endif
extern "C" void kernel_launch(void* const* d_in, const int* in_sizes, int n_in, void* d_out, int out_size, void* d_ws, size_t ws_size, hipStream_t stream) {
    static int grid = 0;
    if (grid == 0) {
        if (n_in != 20 || in_sizes[0] != M * DM || out_size != M * DM || ws_size < WS_END) { fprintf(stderr, "kernel_launch: unexpected shapes (n_in %d, in0 %d, out %d, ws %zu < %zu); nothing launched\n", n_in, n_in > 0 ? in_sizes[0] : -1, out_size, ws_size, (size_t)WS_END); grid = -1; return; }
        int dev = 0, cus = 0, per_cu = 0;
        if (hipGetDevice(&dev) != hipSuccess || hipDeviceGetAttribute(&cus, hipDeviceAttributeMultiprocessorCount, dev) != hipSuccess) { grid = -1; return; }
        if (hipFuncSetAttribute((const void*)fwd_kernel, hipFuncAttributeMaxDynamicSharedMemorySize, LDS_BYTES) != hipSuccess) { fprintf(stderr, "kernel_launch: hipFuncSetAttribute failed\n"); grid = -1; return; }
        if (hipOccupancyMaxActiveBlocksPerMultiprocessor(&per_cu, (const void*)fwd_kernel, NWAVES * 64, LDS_BYTES) != hipSuccess || per_cu < 1) fprintf(stderr, "kernel_launch: occupancy query reports %d\n", per_cu);
        (void)hipGetLastError();
        grid = cus;
    }
    if (grid < 0) return;
    (void)hipMemsetAsync((char*)d_ws + WS_CTL, 0, CTL_ZERO_BYTES, stream);
    Args a{};
    for (int i = 0; i < 20; ++i) a.in[i] = d_in[i];
    a.out = (float*)d_out; a.ws = (unsigned char*)d_ws;
#if MK_ONE_LAUNCH
    a.ph_lo = 0; a.ph_hi = PH_END;
    hipLaunchKernelGGL(fwd_kernel, dim3(grid), dim3(NWAVES * 64), LDS_BYTES, stream, a);
#else
    for (int ph = 0; ph < PH_END; ++ph) {
        if (ph >= PH_L0 && ph < PH_FINAL) { const int l = (ph - PH_L0) / 10, k = (ph - PH_L0) % 10; if (k == 9 || k == 0 || k == 5 || (k == 2 && (l % 3) == 0)) continue; }
        a.ph_lo = ph; a.ph_hi = ph + 1;
        hipLaunchKernelGGL(fwd_kernel, dim3(grid), dim3(NWAVES * 64), LDS_BYTES, stream, a);
    }
#endif
}
```

```cpp
#include <hip/hip_runtime.h>
#include <cstdio>
#include <cstdint>
__device__ __forceinline__ int lane_id_fresh() { unsigned z = 0u; asm volatile("" : "+v"(z));
    return (int)__builtin_amdgcn_mbcnt_hi(~0u, __builtin_amdgcn_mbcnt_lo(~0u, z)); }
constexpr int NWAVES = 8;
constexpr int BATCH = 2, SEQ = 8192, DM = 2048, M = BATCH * SEQ, DFF = 5632, NUP = 2 * DFF, NL = 4;
constexpr int A_IN = 2560, B_IN = 6176, C_IN = 6152, BC_PAD = 6400, YLD = 6144, MODN = 6 * DM;
constexpr float LOG2E = 1.4426950408889634f;
constexpr size_t MiB = 1u << 20;
constexpr size_t WS_CTL = 0, CTL_ZERO_BYTES = 4 * MiB;
constexpr size_t WS_SS = 64 * 1024;
constexpr size_t WS_BIAS = 1280 * 1024;
constexpr float SS_SCALE = 16777216.f, SS_INV = 1.f / 16777216.f, BIAS_SCALE = 68719476736.f, BIAS_INV = 1.f / 68719476736.f;
constexpr int BIAS_A = 0, BIAS_B = 10240, BIAS_C = 23040, BIAS_UP = 35840, BIAS_END = 125952;
static_assert(WS_BIAS + (size_t)BIAS_END * 8 <= CTL_ZERO_BYTES && WS_SS + 9 * 16384 * 8 <= WS_BIAS, "zeroed region");
constexpr size_t WS_MODV = 4 * MiB, WS_RC = 5 * MiB, WS_RS = 7 * MiB, WS_LF = 9 * MiB, WS_FT = 11 * MiB, WS_GI = 13 * MiB, WS_LFC = 14 * MiB, WS_FTC = 15 * MiB;
constexpr size_t WS_WAIN = 16 * MiB, WS_WBIN = 56 * MiB, WS_WCIN = 106 * MiB, WS_WOUT = 156 * MiB, WS_WUP = 188 * MiB, WS_WDN = 540 * MiB;
constexpr size_t WS_X1 = 628 * MiB, WS_HN = 756 * MiB, WS_Y = 820 * MiB, WS_AO = 1012 * MiB, WS_ACT = 1076 * MiB, WS_U = 1252 * MiB, WS_END = 1412 * MiB;
constexpr size_t WS_HU = 1400 * MiB;
constexpr size_t WS_CST = WS_ACT;
constexpr size_t WS_QF = WS_U, WS_KF = WS_U + 32 * MiB, WS_VF = WS_U + 64 * MiB, WS_AF = WS_U + 128 * MiB, WS_EG = WS_U + 136 * MiB;
constexpr int CW_TMO = 0, CW_BAR = 4096, CW_QUEUE = 2048, CW_BGQ = 2048 + 64, CW_SWAQ = 2048 + 128;
constexpr size_t WS_QK2 = 48 * 1024;
constexpr int XCH_OFF = 131072;
constexpr int RING_OFF = 0, RING_BYTES = 155648, LDSCTL_OFF = RING_BYTES, MISC_OFF = LDSCTL_OFF + 320, LDS_BYTES = 163840;
struct Args { const void* in[20]; float* out; unsigned char* ws; int ph_lo, ph_hi; };
namespace pg8 {
#define PG8_LAS __attribute__((address_space(3)))
typedef unsigned short bf16_t;
typedef short bf16x8 __attribute__((ext_vector_type(8)));
typedef float f32x4 __attribute__((ext_vector_type(4)));
typedef unsigned u32x4 __attribute__((ext_vector_type(4)));
constexpr int BM = 256, BK = 64, HALF = 128, HTB = HALF * BK * 2  , STAGE_BYTES = 8 * HTB, NXCD = 8, WGM = 8;

__host__ __device__ __forceinline__ int lds_byte(int r, int c) { const int st = (r >> 4) * 2 + (c >> 5), rr = r & 15, cc = c & 31, ob = rr * 64 + cc * 2; return st * 1024 + (ob ^ (((ob >> 9) & 1) << 5)); }
__host__ __device__ __forceinline__ void stage_rc(int b, int& R, int& C) { const int st = b / 1024, sb = b % 1024, swz = sb ^ (((sb >> 9) & 1) << 5); R = (st >> 1) * 16 + swz / 64; C = (st & 1) * 32 + (swz % 64) / 2; }
__host__ __device__ __forceinline__ int perm32(int rho) { const int n = rho >> 4, i = rho & 15; return 8 * (i >> 2) + 4 * n + (i & 3); }

struct Unit { int pm, pn; };
struct Gemm { const bf16_t* A; const bf16_t* Bt; int M, N, K; size_t bstride; };

struct StaticOrder {
    int nM, nN, nwg, G, c;
    __host__ __device__ void init(int M, int N, int G_, int c_) { nM = M / BM; nN = N / BM; nwg = nM * nN; G = G_; c = c_; }
    __host__ __device__ bool next(int i, Unit& u) const {
        const long L = (long)i * G + c; if (L >= nwg) return false;
        int wgid = (int)L; { const int q = nwg / NXCD, r = nwg % NXCD, xcd = wgid % NXCD, off = wgid / NXCD; wgid = (xcd < r ? xcd * (q + 1) : r * (q + 1) + (xcd - r) * q) + off; }
        const int nig = WGM * nN, gid = wgid / nig, fm = gid * WGM, gsz = (nM - fm) < WGM ? (nM - fm) : WGM;
        u.pm = fm + ((wgid % nig) % gsz); u.pn = (wgid % nig) / gsz; return true;
    }
    __device__ __forceinline__ void a_ready(const Unit&) const {}
    __device__ __forceinline__ void done(const Unit&) const {}
};

__device__ __forceinline__ unsigned cvt_pk_bf16(float lo, float hi) { unsigned r; asm volatile("v_cvt_pk_bf16_f32 %0, %1, %2" : "=v"(r) : "v"(lo), "v"(hi)); return r; }
typedef float f32x2 __attribute__((ext_vector_type(2)));
template <class Epi, class Sched, bool ALIGN_EPI = false, bool SP2 = false>
__device__ __forceinline__ void gemm_phase(PG8_LAS unsigned char* lds, const Gemm g, const Sched& S, const Epi& E, const int wv  ) {
    if constexpr (Epi::SKEW > 0) { if ((blockIdx.x >> 3) & 1) {
#pragma unroll 1
        for (int i_ = 0; i_ < Epi::SKEW; ++i_) __builtin_amdgcn_s_sleep(16); } }
    int tid_ = wv * 64 + lane_id_fresh();
    const int tid = tid_, wid = __builtin_amdgcn_readfirstlane(tid >> 6), lane = tid & 63, wr = wid >> 2, wc = wid & 3, fr = lane & 15, fq = lane >> 4;
    const int K = g.K, nt = K / BK;
    unsigned voffA[2], voffB[2];
#pragma unroll
    for (int i = 0; i < 2; ++i) { int R, C; stage_rc(tid * 16 + i * 8192, R, C); const int Rb = Epi::PERM ? ((R & ~31) + perm32(R & 31)) : R;
        voffA[i] = (unsigned)(R * K + C) * 2u; voffB[i] = (unsigned)(Rb * K + C) * 2u; }
    voffA[1] = voffA[0] + 128u * (unsigned)K; voffB[1] = voffB[0] + 128u * (unsigned)K;
    const size_t kstep = (size_t)(BK * 2);
    const size_t hstep = (size_t)HALF * K * 2;
    const size_t tstep = 2 * hstep;
    const unsigned ldsw = (unsigned)wid * 1024u;
    const int aoff = lds_byte(wr * 64 + fr, fq * 8), boff = lds_byte(wc * 32 + fr, fq * 8);
#define PG8_SA(b, h) (((b) * 2 + (h)) * HTB)
#define PG8_SB(b, h) ((4 + (b) * 2 + (h)) * HTB)
#define PG8_STAGE(bufoff, gbase, voff) do { _Pragma("unroll") for (int _i = 0; _i < 2; ++_i) \
        __builtin_amdgcn_global_load_lds((const unsigned*)((const char*)(gbase) + (voff)[_i]), (PG8_LAS unsigned*)(lds + (bufoff) + ldsw + _i * 8192), 16, 0, 0); } while (0)
#define PG8_LDA(dst, b, h) do { _Pragma("unroll") for (int m = 0; m < 4; ++m) _Pragma("unroll") for (int k = 0; k < 2; ++k) dst[m][k] = *(const PG8_LAS bf16x8*)(lds + PG8_SA(b, h) + aoff + m * 2048 + k * 1024); } while (0)
#define PG8_LDB(dst, b, h) do { _Pragma("unroll") for (int n = 0; n < 2; ++n) _Pragma("unroll") for (int k = 0; k < 2; ++k) dst[n][k] = *(const PG8_LAS bf16x8*)(lds + PG8_SB(b, h) + boff + n * 2048 + k * 1024); } while (0)
#define PG8_MMA(ai, bj, At, Bt) do { __builtin_amdgcn_s_setprio(1); _Pragma("unroll") for (int m = 0; m < 4; ++m) _Pragma("unroll") for (int n = 0; n < 2; ++n) _Pragma("unroll") for (int k = 0; k < 2; ++k) \
        acc[ai][bj][m][n] = __builtin_amdgcn_mfma_f32_16x16x32_bf16(Bt[n][k], At[m][k], acc[ai][bj][m][n], 0, 0, 0); __builtin_amdgcn_s_setprio(0); } while (0)
#define PG8_WAIT_V(n) asm volatile("s_waitcnt vmcnt(" #n ")" ::: "memory")
#define PG8_WAIT_L(n) asm volatile("s_waitcnt lgkmcnt(" #n ")" ::: "memory")
#define PG8_BAR __builtin_amdgcn_s_barrier()
#define PG8_SCHED __builtin_amdgcn_sched_barrier(0)
    Unit cur, nxt; int ui = 0;
    if (!S.next(0, cur)) return;
    f32x4 acc[2][2][4][2];
#pragma unroll
    for (int a = 0; a < 2; ++a)
#pragma unroll
        for (int b = 0; b < 2; ++b)
#pragma unroll
            for (int m = 0; m < 4; ++m)
#pragma unroll
                for (int n = 0; n < 2; ++n) acc[a][b][m][n] = (f32x4){0.f, 0.f, 0.f, 0.f};
    bf16x8 At[4][2], B0[2][2], B1[2][2];
    const char* cA = (const char*)g.A + (size_t)cur.pm * tstep; const char* cB = (const char*)g.Bt + (size_t)cur.pn * tstep + (cur.pm >= 32 ? g.bstride * 2 : 0);
    S.a_ready(cur);
    if constexpr (SP2) {
        PG8_STAGE(PG8_SB(0, 0), cB, voffB); PG8_STAGE(PG8_SB(0, 1), cB + hstep, voffB); PG8_STAGE(PG8_SA(0, 0), cA, voffA); PG8_STAGE(PG8_SA(0, 1), cA + hstep, voffA);
        if (wr == 1) PG8_BAR;
        PG8_WAIT_V(2); PG8_BAR;
        PG8_STAGE(PG8_SB(1, 0), cB + kstep, voffB); PG8_STAGE(PG8_SA(1, 0), cA + kstep, voffA); PG8_STAGE(PG8_SB(1, 1), cB + hstep + kstep, voffB);
        PG8_WAIT_V(6); PG8_BAR;
    } else {
        PG8_STAGE(PG8_SB(0, 0), cB, voffB); PG8_STAGE(PG8_SA(0, 0), cA, voffA); PG8_STAGE(PG8_SB(0, 1), cB + hstep, voffB); PG8_STAGE(PG8_SA(0, 1), cA + hstep, voffA);
        if (wr == 1) PG8_BAR;
        PG8_WAIT_V(4); PG8_BAR;
        PG8_STAGE(PG8_SB(1, 0), cB + kstep, voffB); PG8_STAGE(PG8_SA(1, 0), cA + kstep, voffA); PG8_STAGE(PG8_SB(1, 1), cB + hstep + kstep, voffB);
        PG8_WAIT_V(6); PG8_BAR;
    }
    for (;;) {
        const bool has_next = S.next(ui + 1, nxt);
        if constexpr (Epi::HAS_PF) E.prefetch(cur, ui & 1, wid, lane_id_fresh()  );
        const char* nA = has_next ? (const char*)g.A + (size_t)nxt.pm * tstep : cA; const char* nB = has_next ? (const char*)g.Bt + (size_t)nxt.pn * tstep + (nxt.pm >= 32 ? g.bstride * 2 : 0) : cB;
        for (int t = 0; t < nt; t += 2) {
            const bool last = (t == nt - 2);
            const char* a1 = cA + (size_t)(t + 1) * kstep;
            const char* a2 = last ? nA : cA + (size_t)(t + 2) * kstep; const char* b2 = last ? nB : cB + (size_t)(t + 2) * kstep;
            const char* a3 = a2 + kstep; const char* b3 = b2 + kstep;
            if (last && has_next) S.a_ready(nxt);
            if constexpr (SP2) {
            PG8_LDB(B0, 0, 0); PG8_LDB(B1, 0, 1); PG8_SCHED; PG8_LDA(At, 0, 0); PG8_STAGE(PG8_SA(1, 1), a1 + hstep, voffA);
            PG8_WAIT_V(8); PG8_WAIT_L(0); PG8_BAR; PG8_MMA(0, 0, At, B0); PG8_MMA(0, 1, At, B1); PG8_BAR; PG8_SCHED;
            PG8_LDA(At, 0, 1); PG8_STAGE(PG8_SB(0, 0), b2, voffB); PG8_STAGE(PG8_SB(0, 1), b2 + hstep, voffB); PG8_STAGE(PG8_SA(0, 0), a2, voffA);
            PG8_WAIT_V(8); PG8_WAIT_L(0); PG8_BAR; PG8_MMA(1, 0, At, B0); PG8_MMA(1, 1, At, B1); PG8_BAR; PG8_SCHED;
            PG8_LDB(B0, 1, 0); PG8_LDB(B1, 1, 1); PG8_SCHED; PG8_LDA(At, 1, 0); PG8_STAGE(PG8_SA(0, 1), a2 + hstep, voffA);
            PG8_WAIT_V(8); PG8_WAIT_L(0); PG8_BAR; PG8_MMA(0, 0, At, B0); PG8_MMA(0, 1, At, B1); PG8_BAR; PG8_SCHED;
            PG8_LDA(At, 1, 1); PG8_STAGE(PG8_SB(1, 0), b3, voffB); PG8_STAGE(PG8_SB(1, 1), b3 + hstep, voffB); PG8_STAGE(PG8_SA(1, 0), a3, voffA);
            PG8_WAIT_V(8); PG8_WAIT_L(0); PG8_BAR; PG8_MMA(1, 0, At, B0); PG8_MMA(1, 1, At, B1); PG8_BAR; PG8_SCHED;
            } else {
            PG8_LDB(B0, 0, 0); PG8_SCHED; PG8_LDA(At, 0, 0); PG8_STAGE(PG8_SA(1, 1), a1 + hstep, voffA);
            PG8_WAIT_L(8); PG8_BAR; PG8_WAIT_L(0); PG8_MMA(0, 0, At, B0); PG8_BAR; PG8_SCHED;
            PG8_LDB(B1, 0, 1); PG8_STAGE(PG8_SB(0, 0), b2, voffB);
            PG8_BAR; PG8_WAIT_L(0); PG8_MMA(0, 1, At, B1); PG8_BAR;
            PG8_LDA(At, 0, 1); PG8_STAGE(PG8_SA(0, 0), a2, voffA);
            PG8_BAR; PG8_WAIT_L(0); PG8_MMA(1, 0, At, B0); PG8_BAR; PG8_SCHED;
            PG8_STAGE(PG8_SB(0, 1), b2 + hstep, voffB);
            PG8_WAIT_V(6); PG8_BAR; PG8_MMA(1, 1, At, B1); PG8_BAR;
            PG8_LDB(B0, 1, 0); PG8_SCHED; PG8_LDA(At, 1, 0); PG8_STAGE(PG8_SA(0, 1), a2 + hstep, voffA);
            PG8_WAIT_L(8); PG8_BAR; PG8_WAIT_L(0); PG8_MMA(0, 0, At, B0); PG8_BAR; PG8_SCHED;
            PG8_LDB(B1, 1, 1); PG8_STAGE(PG8_SB(1, 0), b3, voffB);
            PG8_BAR; PG8_WAIT_L(0); PG8_MMA(0, 1, At, B1); PG8_BAR;
            PG8_LDA(At, 1, 1); PG8_STAGE(PG8_SA(1, 0), a3, voffA);
            PG8_BAR; PG8_WAIT_L(0); PG8_MMA(1, 0, At, B0); PG8_BAR; PG8_SCHED;
            PG8_STAGE(PG8_SB(1, 1), b3 + hstep, voffB);
            PG8_WAIT_V(6); PG8_BAR; PG8_MMA(1, 1, At, B1); PG8_BAR;
            }
        }
        if constexpr (ALIGN_EPI) { if (wr == 0) PG8_BAR; }
        if constexpr (!Epi::AFTER_DRAIN) { int t2_ = lane_id_fresh();
#if defined(PROBE_EPIN) && PROBE_EPIN
            if constexpr (Epi::EPI_KIND == PROBE_EPIN) { int nrep_ = 2; asm volatile("" : "+s"(nrep_));
                for (int rep_ = 0; rep_ < nrep_; ++rep_) { if constexpr (Epi::HAS_PF) E(acc, cur, wr, wc, t2_ & 15, (t2_ >> 4) & 3, (ui & 1) | (rep_ ? 2 : 0)); else { Epi E2 = E; E2.prb = rep_; E2(acc, cur, wr, wc, t2_ & 15, (t2_ >> 4) & 3); } asm volatile("" ::: "memory"); }
            } else
#endif
            { if constexpr (Epi::HAS_PF) E(acc, cur, wr, wc, t2_ & 15, (t2_ >> 4) & 3, ui & 1); else E(acc, cur, wr, wc, t2_ & 15, (t2_ >> 4) & 3); }
            S.done(cur); }
        if (!has_next) break;
#pragma unroll
        for (int a = 0; a < 2; ++a)
#pragma unroll
            for (int b = 0; b < 2; ++b)
#pragma unroll
                for (int m = 0; m < 4; ++m)
#pragma unroll
                    for (int n = 0; n < 2; ++n) acc[a][b][m][n] = (f32x4){0.f, 0.f, 0.f, 0.f};
        cur = nxt; cA = nA; cB = nB; ++ui;
        if constexpr (ALIGN_EPI) { if (wr == 1) PG8_BAR; }
    }
    PG8_WAIT_V(0);
    if constexpr (!ALIGN_EPI) { if (wr == 0) PG8_BAR; }
    PG8_BAR;
    if constexpr (Epi::AFTER_DRAIN) { E.fused(acc, cur, wr, wc, fr, fq, lds, wid, lane); S.done(cur); }
#undef PG8_SA
#undef PG8_SB
#undef PG8_STAGE
#undef PG8_LDA
#undef PG8_LDB
#undef PG8_MMA
#undef PG8_WAIT_V
#undef PG8_WAIT_L
#undef PG8_BAR
#undef PG8_SCHED
}
#ifndef SKEW_IN
#define SKEW_IN 0
#define SKEW_RES 0
#define SKEW_UP 0
#endif
typedef unsigned u32x2 __attribute__((ext_vector_type(2)));
__device__ __forceinline__ float log_sigmoid_f(float x) { return fminf(x, 0.f) - __logf(1.f + __expf(-fabsf(x))); }
__device__ __forceinline__ void st_bf16x8(bf16_t* p, f32x4 v0, f32x4 v1) { u32x4 w; w.x = cvt_pk_bf16(v0[0], v0[1]); w.y = cvt_pk_bf16(v0[2], v0[3]); w.z = cvt_pk_bf16(v1[0], v1[1]); w.w = cvt_pk_bf16(v1[2], v1[3]); *(u32x4*)p = w; }

typedef const __attribute__((address_space(4))) Args* kargs_t;
__device__ __forceinline__ kargs_t kargs() { kargs_t a = (kargs_t)__builtin_amdgcn_kernarg_segment_ptr(); asm volatile("" : "+s"(a)); return a; }
typedef unsigned u32x4n __attribute__((ext_vector_type(4)));
__device__ __forceinline__ float fx2f(unsigned lo, unsigned hi) { return (float)(int)hi * 4294967296.f + (float)lo; }
__device__ __forceinline__ void apply_norm(f32x4 (&acc)[2][2][4][2], const long long* ss, const long long* bp, int row0) {
    f32x4 bv[2][2];
#pragma unroll
    for (int bj = 0; bj < 2; ++bj)
#pragma unroll
        for (int n = 0; n < 2; ++n) { const u32x4n a = *(const u32x4n*)(bp + bj * HALF + 4 * n), b = *(const u32x4n*)(bp + bj * HALF + 4 * n + 2);
            bv[bj][n] = (f32x4){fx2f(a[0], a[1]) * BIAS_INV, fx2f(a[2], a[3]) * BIAS_INV, fx2f(b[0], b[1]) * BIAS_INV, fx2f(b[2], b[3]) * BIAS_INV}; }
#pragma unroll
    for (int ai = 0; ai < 2; ++ai)
#pragma unroll
        for (int m = 0; m < 4; ++m) { typedef unsigned u32x2n __attribute__((ext_vector_type(2))); const u32x2n sv = *(const u32x2n*)(ss + row0 + ai * HALF + m * 16);
            const float rstd = __builtin_amdgcn_rsqf(fx2f(sv[0], sv[1]) * (SS_INV / 2048.f) + 1e-6f);
#pragma unroll
            for (int bj = 0; bj < 2; ++bj)
#pragma unroll
                for (int n = 0; n < 2; ++n) acc[ai][bj][m][n] = acc[ai][bj][m][n] * rstd + bv[bj][n]; }
    __builtin_amdgcn_sched_barrier(0);
}
__device__ __forceinline__ void apply_norm_lds(f32x4 (&acc)[2][2][4][2], const PG8_LAS long long* ss  , const PG8_LAS long long* bp  , int rowl) {
    f32x4 bv[2][2];
#pragma unroll
    for (int bj = 0; bj < 2; ++bj)
#pragma unroll
        for (int n = 0; n < 2; ++n) { const u32x4n a = *(const PG8_LAS u32x4n*)(bp + bj * HALF + 4 * n), b = *(const PG8_LAS u32x4n*)(bp + bj * HALF + 4 * n + 2);
            bv[bj][n] = (f32x4){fx2f(a[0], a[1]) * BIAS_INV, fx2f(a[2], a[3]) * BIAS_INV, fx2f(b[0], b[1]) * BIAS_INV, fx2f(b[2], b[3]) * BIAS_INV}; }
#pragma unroll
    for (int ai = 0; ai < 2; ++ai)
#pragma unroll
        for (int m = 0; m < 4; ++m) { typedef unsigned u32x2n __attribute__((ext_vector_type(2))); const u32x2n sv = *(const PG8_LAS u32x2n*)(ss + rowl + ai * HALF + m * 16);
            const float rstd = __builtin_amdgcn_rsqf(fx2f(sv[0], sv[1]) * (SS_INV / 2048.f) + 1e-6f);
#pragma unroll
            for (int bj = 0; bj < 2; ++bj)
#pragma unroll
                for (int n = 0; n < 2; ++n) acc[ai][bj][m][n] = acc[ai][bj][m][n] * rstd + bv[bj][n]; }
    __builtin_amdgcn_sched_barrier(0);
}
template <int KIND> struct EpiIn {
    static constexpr bool PERM = true, AFTER_DRAIN = false, TWICE = false, HAS_PF = false;
    static constexpr int EPI_KIND = 1;
    static constexpr int SKEW = SKEW_IN;
    int l, prb;
    __device__ __forceinline__ void operator()(f32x4 (&acc)[2][2][4][2], const Unit& u, int wr, int wc, int fr, int fq) const {
        asm volatile("" : "+v"(fr), "+v"(fq)); asm volatile("" : "+s"(wr), "+s"(wc));
        const kargs_t ap = kargs(); unsigned char* ws = ap->ws; const int j = l / 3;
        bf16_t* Y = (bf16_t*)(ws + WS_Y); constexpr int ldy = (KIND == 0) ? 2560 : 6144, npad = (KIND == 0) ? 2560 : 6400;
        const float* rc = (const float*)(ws + WS_RC); const float* rs = (const float*)(ws + WS_RS);
        float* G0 = (float*)(ws + (KIND == 1 ? WS_LF : WS_GI)); float* G1 = (float*)(ws + WS_LFC);
        const float* gbias = (KIND == 1) ? (const float*)ap->in[11] + j * 32 : (const float*)ap->in[14] + j * 8;
        const long long* ss = (const long long*)(ws + WS_SS) + (size_t)(2 * l) * 16384;
        const long long* bias = (const long long*)(ws + WS_BIAS) + (KIND == 0 ? BIAS_A + j * 2 * 2560 : KIND == 1 ? BIAS_B : BIAS_C);
        const int row0 = u.pm * BM + wr * 64 + fr, ct = u.pn * BM + wc * 32 + 8 * fq;
        if (!prb) apply_norm(acc, ss, bias + (u.pm >= 32 ? npad : 0) + ct, row0);
        if (KIND != 0 && u.pn == 24) {
            if (wc == 0) {
#pragma unroll
                for (int ai = 0; ai < 2; ++ai)
#pragma unroll
                    for (int m = 0; m < 4; ++m) { const int row = row0 + ai * HALF + m * 16; const f32x4 v0 = acc[ai][0][m][0], v1 = acc[ai][0][m][1];
                        if (KIND == 1) { f32x4 a, b;
#pragma unroll
                            for (int e = 0; e < 4; ++e) { a[e] = log_sigmoid_f(v0[e] + gbias[8 * fq + e]); b[e] = log_sigmoid_f(v1[e] + gbias[8 * fq + 4 + e]); }
                            *(f32x4*)(G0 + (size_t)row * 32 + 8 * fq) = a; *(f32x4*)(G0 + (size_t)row * 32 + 8 * fq + 4) = b; }
                        else if (fq == 0) { f32x4 a, b;
#pragma unroll
                            for (int e = 0; e < 4; ++e) { a[e] = v0[e] + gbias[e]; b[e] = log_sigmoid_f(v1[e] + gbias[4 + e]); }
                            *(f32x4*)(G0 + (size_t)row * 4) = a; *(f32x4*)(G1 + (size_t)row * 4) = b; } }
            }
            return;
        }
        if (KIND == 1 && u.pn < 16) {
            const float s2 = (u.pn < 8) ? (0.125f * 1.4426950408889634f) * (0.125f * 1.4426950408889634f) : 1.f;
            unsigned* qk2 = (unsigned*)(ws + WS_QK2); const int ln = fq * 16 + fr;
#pragma unroll
            for (int bj = 0; bj < 2; ++bj) { float mx = 0.f;
#pragma unroll
                for (int ai = 0; ai < 2; ++ai)
#pragma unroll
                    for (int m = 0; m < 4; ++m) { const f32x4 a = acc[ai][bj][m][0], c = acc[ai][bj][m][1];
                        float s = (a[0] * a[0] + a[1] * a[1]) + (a[2] * a[2] + a[3] * a[3]) + (c[0] * c[0] + c[1] * c[1]) + (c[2] * c[2] + c[3] * c[3]);
                        s += __int_as_float(__builtin_amdgcn_ds_bpermute((ln ^ 16) << 2, __float_as_int(s))); s += __int_as_float(__builtin_amdgcn_ds_bpermute((ln ^ 32) << 2, __float_as_int(s)));
                        mx = fmaxf(mx, s); }
#pragma unroll
                for (int o = 1; o < 16; o <<= 1) mx = fmaxf(mx, __int_as_float(__builtin_amdgcn_ds_bpermute((ln ^ o) << 2, __float_as_int(mx))));
                const int colh = (u.pn & 7) * BM + bj * HALF + wc * 32;
                if (ln == 0) atomicMax(qk2 + (((u.pm >= 32 ? 32 : 0) + (colh >> 6)) * 4 + (u.pn < 8 ? 0 : 2) + ((colh >> 5) & 1)), __float_as_uint(mx * s2 * 1.0001f)); } }
        float sc = 1.f; if (KIND <= 1 && u.pn < 8) sc = 0.125f * 1.4426950408889634f;     if (KIND == 2 && u.pn < 4) sc = 0.0625f;
        const bool rope = (KIND == 0) && (u.pn < 9); const int j4 = 4 * (4 * (wc & 1) + fq);
#pragma unroll
        for (int ai = 0; ai < 2; ++ai)
#pragma unroll
            for (int m = 0; m < 4; ++m) { const int row = row0 + ai * HALF + m * 16; bf16_t* rowp = Y + (size_t)row * ldy + ct;
                f32x4 c4 = {1.f, 1.f, 1.f, 1.f}, s4 = {0.f, 0.f, 0.f, 0.f};
                if (rope) { c4 = *(const f32x4*)(rc + (size_t)row * 32 + j4); s4 = *(const f32x4*)(rs + (size_t)row * 32 + j4); }
#pragma unroll
                for (int bj = 0; bj < 2; ++bj) { f32x4 v0 = acc[ai][bj][m][0], v1 = acc[ai][bj][m][1];
                    if (KIND == 0) { const f32x4 o0 = v0 * c4 - v1 * s4, o1 = v1 * c4 + v0 * s4; v0 = o0 * sc; v1 = o1 * sc; } else { v0 = v0 * sc; v1 = v1 * sc; }
                    st_bf16x8(rowp + bj * HALF, v0, v1); } }
    }
};
struct EpiPlain {
    static constexpr bool PERM = true, AFTER_DRAIN = false, TWICE = false, HAS_PF = false;
    static constexpr int EPI_KIND = 0;
    static constexpr int SKEW = 0;
    bf16_t* Y; int ldy;
    __device__ __forceinline__ void operator()(const f32x4 (&acc)[2][2][4][2], const Unit& u, int wr, int wc, int fr, int fq) const {
        asm volatile("" : "+v"(fr), "+v"(fq)); asm volatile("" : "+s"(wr), "+s"(wc));
        const int row0 = u.pm * BM + wr * 64 + fr, ct = u.pn * BM + wc * 32 + 8 * fq;
#pragma unroll
        for (int ai = 0; ai < 2; ++ai)
#pragma unroll
            for (int m = 0; m < 4; ++m) { bf16_t* rowp = Y + (size_t)(row0 + ai * HALF + m * 16) * ldy + ct;
#pragma unroll
                for (int bj = 0; bj < 2; ++bj) st_bf16x8(rowp + bj * HALF, acc[ai][bj][m][0], acc[ai][bj][m][1]); }
    }
};
struct EpiRes {
    static constexpr bool PERM = true, AFTER_DRAIN = false, TWICE = true, HAS_PF = false;
    static constexpr int EPI_KIND = 2;
    static constexpr int SKEW = SKEW_RES;
    int l, which, prb; PG8_LAS float* sx;
    __device__ __forceinline__ void operator()(const f32x4 (&acc)[2][2][4][2], const Unit& u, int wr, int wc, int fr, int fq) const {
        asm volatile("" : "+v"(fr), "+v"(fq)); asm volatile("" : "+s"(wr), "+s"(wc));
        const kargs_t ap = kargs(); unsigned char* ws = ap->ws;
        const bf16_t* xi = (const bf16_t*)(ws + (which ? WS_X1 : WS_HN)); bf16_t* xo = (bf16_t*)(ws + (which ? WS_HN : WS_X1));
        unsigned long long* ssq = (unsigned long long*)(ws + WS_SS) + (size_t)(2 * l + 1 + which) * 16384;
        const float* g = (const float*)(ws + WS_MODV) + (size_t)l * 2 * 12288 + (which ? 5 : 2) * 2048 + (u.pm >= 32 ? 12288 : 0);
        const int col0 = u.pn * BM + wc * 32 + 8 * fq;
        const int rb = u.pm * BM + wr * 64, pl = 16 * (fr & 3) + (fr >> 2);
        const int xi0 = rb + (which ? pl : fr), xis = which ? 4 : 16, xo0 = rb + (which ? fr : pl), xos = which ? 16 : 4;
        u32x4 bw[2][4][2];
#pragma unroll
        for (int ai = 0; ai < 2; ++ai)
#pragma unroll
            for (int m = 0; m < 4; ++m)
#pragma unroll
                for (int bj = 0; bj < 2; ++bj) bw[ai][m][bj] = *(const u32x4*)(xi + (size_t)(xi0 + ai * HALF + m * xis) * 2048 + col0 + bj * HALF);
        f32x4 gv[2][2];
#pragma unroll
        for (int bj = 0; bj < 2; ++bj)
#pragma unroll
            for (int n = 0; n < 2; ++n) gv[bj][n] = *(const f32x4*)(g + col0 + bj * HALF + 4 * n);
        __builtin_amdgcn_sched_barrier(0);
        float sv[2][4];
#pragma unroll
        for (int ai = 0; ai < 2; ++ai)
#pragma unroll
            for (int m = 0; m < 4; ++m) { const size_t off = (size_t)(xo0 + ai * HALF + m * xos) * 2048 + col0; float s = 0.f;
#pragma unroll
                for (int bj = 0; bj < 2; ++bj) { const u32x4 w = bw[ai][m][bj];
                    const f32x4 b0 = {__uint_as_float(w.x << 16), __uint_as_float(w.x & 0xffff0000u), __uint_as_float(w.y << 16), __uint_as_float(w.y & 0xffff0000u)};
                    const f32x4 b1 = {__uint_as_float(w.z << 16), __uint_as_float(w.z & 0xffff0000u), __uint_as_float(w.w << 16), __uint_as_float(w.w & 0xffff0000u)};
                    const f32x4 o0 = b0 + gv[bj][0] * acc[ai][bj][m][0], o1 = b1 + gv[bj][1] * acc[ai][bj][m][1];
                    st_bf16x8(xo + off + bj * HALF, o0, o1);
                    s += (o0[0] * o0[0] + o0[1] * o0[1]) + (o0[2] * o0[2] + o0[3] * o0[3]) + (o1[0] * o1[0] + o1[1] * o1[1]) + (o1[2] * o1[2] + o1[3] * o1[3]); }
                { const int ln = fq * 16 + fr; s += __int_as_float(__builtin_amdgcn_ds_bpermute((ln ^ 16) << 2, __float_as_int(s))); s += __int_as_float(__builtin_amdgcn_ds_bpermute((ln ^ 32) << 2, __float_as_int(s))); }
                sv[ai][m] = s; }
        __builtin_amdgcn_sched_barrier(0);
        if (fq == 0) {
#pragma unroll
            for (int ai = 0; ai < 2; ++ai)
#pragma unroll
                for (int m = 0; m < 4; ++m) sx[wc * 256 + (xo0 - u.pm * BM) + ai * HALF + m * xos] = sv[ai][m];
        }
        asm volatile("s_waitcnt lgkmcnt(0)\n\ts_barrier" ::: "memory"); __builtin_amdgcn_sched_barrier(0);
        if (fq == 0 && !prb) {
#pragma unroll
            for (int hh = 0; hh < 2; ++hh) { const int rr = (wr * 4 + wc) * 16 + fr + 128 * hh;
                const float s = (sx[rr] + sx[256 + rr]) + (sx[512 + rr] + sx[768 + rr]);
                atomicAdd(ssq + u.pm * BM + rr, (unsigned long long)(s * SS_SCALE)); }
        }
    }
};
__device__ __forceinline__ float dpp_shr1(float old, float v) { return __int_as_float(__builtin_amdgcn_update_dpp(__float_as_int(old), __float_as_int(v), 0x111, 0xf, 0xf, false)); }
struct EpiUp {
    static constexpr bool PERM = true, AFTER_DRAIN = false, TWICE = false, HAS_PF = true;
    static constexpr int EPI_KIND = 3;
    static constexpr int SKEW = SKEW_UP;
    int l; PG8_LAS float* xch; PG8_LAS float* pf;
    __device__ __forceinline__ void prefetch(const Unit& u, int par, int wid, int lane) const {
        constexpr int NUPc = 11264, DFFc = 5632;
        const kargs_t ap = kargs(); unsigned char* ws = ap->ws;
        const unsigned dst = (unsigned)(uintptr_t)(pf + par * 2048) + wid * 1024;
        const char* src;
        if (wid < 2) src = (const char*)((const long long*)(ws + WS_SS) + (size_t)(2 * l + 1) * 16384 + u.pm * BM + wid * 128 + lane * 2);
        else if (wid < 4) src = (const char*)((const long long*)(ws + WS_BIAS) + BIAS_UP + (size_t)l * 2 * NUPc + (u.pm >= 32 ? NUPc : 0) + u.pn * BM + (wid - 2) * 128 + lane * 2);
        else { const int a = wid - 4, col = (lane < 32) ? u.pn * HALF + 4 * lane : DFFc + u.pn * HALF + 4 * (lane - 32);
            src = (const char*)((a < 3 ? (const float*)ap->in[17] + (size_t)l * 3 * NUPc + (size_t)a * NUPc : (const float*)ap->in[18] + (size_t)l * NUPc) + col); }
        unsigned keep; asm volatile("s_mov_b32 %0, m0\n\ts_mov_b32 m0, %2\n\ts_nop 0\n\tglobal_load_lds_dwordx4 %1, off\n\ts_mov_b32 m0, %0" : "=&s"(keep) : "v"(src), "s"((unsigned)__builtin_amdgcn_readfirstlane(dst)) : "memory");
    }
    __device__ __forceinline__ void operator()(f32x4 (&acc)[2][2][4][2], const Unit& u, int wr, int wc, int fr, int fq, int par) const {
        asm volatile("" : "+v"(fr), "+v"(fq)); asm volatile("" : "+s"(wr), "+s"(wc));
        const bool renorm = !(par & 2); par &= 1;
        const PG8_LAS unsigned char* pfb = (const PG8_LAS unsigned char*)(pf + par * 2048);
        constexpr int NUPc = 11264, DFFc = 5632;
        const kargs_t ap = kargs(); unsigned char* ws = ap->ws;
        bf16_t* ACT = (bf16_t*)(ws + WS_ACT); float* HU = (float*)(ws + WS_HU);
        const float* cw = (const float*)ap->in[17] + (size_t)l * 3 * NUPc; const float* cb = (const float*)ap->in[18] + (size_t)l * NUPc;
        const long long* ss = (const long long*)(ws + WS_SS) + (size_t)(2 * l + 1) * 16384; const long long* bias = (const long long*)(ws + WS_BIAS) + BIAS_UP + (size_t)l * 2 * NUPc;
        const int wid = wr * 4 + wc;
        if (renorm) apply_norm_lds(acc, (const PG8_LAS long long*)pfb, (const PG8_LAS long long*)(pfb + 2048) + wc * 32 + 8 * fq, wr * 64 + fr);
        if (fr == 15) {
#pragma unroll
            for (int ai = 0; ai < 2; ++ai)
#pragma unroll
                for (int bj = 0; bj < 2; ++bj)
#pragma unroll
                    for (int n = 0; n < 2; ++n) { *(PG8_LAS f32x4*)(xch + ((wid * 2 + ai) * 2 + 0) * 64 + bj * 32 + fq * 8 + n * 4) = acc[ai][bj][2][n]; *(PG8_LAS f32x4*)(xch + ((wid * 2 + ai) * 2 + 1) * 64 + bj * 32 + fq * 8 + n * 4) = acc[ai][bj][3][n]; }
        }
        { const int pc = u.pn * BM + wc * 32 + fq * 8;
          if (wr == 0 && fr == 0) {
#pragma unroll
            for (int k = 0; k < 2; ++k)
#pragma unroll
              for (int bj = 0; bj < 2; ++bj)
#pragma unroll
                for (int n = 0; n < 2; ++n) *(f32x4*)(HU + (size_t)(u.pm * 4 + k) * NUPc + pc + bj * HALF + n * 4) = acc[0][bj][k][n];
          }
          if (wr == 1 && fr == 15) {
#pragma unroll
            for (int k = 0; k < 2; ++k)
#pragma unroll
              for (int bj = 0; bj < 2; ++bj)
#pragma unroll
                for (int n = 0; n < 2; ++n) *(f32x4*)(HU + (size_t)(u.pm * 4 + 2 + k) * NUPc + pc + bj * HALF + n * 4) = acc[1][bj][2 + k][n];
          } }
        asm volatile("s_waitcnt lgkmcnt(0)\n\ts_barrier" ::: "memory"); __builtin_amdgcn_sched_barrier(0);
        const int j0 = u.pn * HALF + wc * 32 + fq * 8;
        const int row0 = u.pm * BM + wr * 64 + 4 * fr;
        bf16_t* const arow = ACT + (size_t)row0 * DFFc + j0;
        typedef float f32x2 __attribute__((ext_vector_type(2)));
#pragma unroll
        for (int n = 0; n < 2; ++n) {
            f32x4 w0[2], w1[2], w2[2], bb[2];
#pragma unroll
            for (int bj = 0; bj < 2; ++bj) { const PG8_LAS float* wp = (const PG8_LAS float*)(pfb + 4096) + bj * 128 + wc * 32 + fq * 8 + 4 * n;
                w0[bj] = *(const PG8_LAS f32x4*)wp; w1[bj] = *(const PG8_LAS f32x4*)(wp + 256); w2[bj] = *(const PG8_LAS f32x4*)(wp + 512); bb[bj] = *(const PG8_LAS f32x4*)(wp + 768); }
#pragma unroll
            for (int ai = 0; ai < 2; ++ai) {
                __builtin_amdgcn_sched_barrier(0);
                f32x4 y[2][4];
                const bool first = (wr == 0 && ai == 0);
                const int sw = (wr == 1) ? wc : 4 + wc, sai = (wr == 1) ? ai : ai - 1;
#pragma unroll
                for (int bj = 0; bj < 2; ++bj) {
                    f32x4 A = {0.f, 0.f, 0.f, 0.f}, B = A;
                    if (!first) { A = *(const PG8_LAS f32x4*)(xch + ((sw * 2 + sai) * 2 + 1) * 64 + bj * 32 + fq * 8 + n * 4); B = *(const PG8_LAS f32x4*)(xch + ((sw * 2 + sai) * 2 + 0) * 64 + bj * 32 + fq * 8 + n * 4); }
#pragma unroll
                    for (int e = 0; e < 4; e += 2) {
                        const f32x2 W0 = {w0[bj][e], w0[bj][e + 1]}, W1 = {w1[bj][e], w1[bj][e + 1]}, W2 = {w2[bj][e], w2[bj][e + 1]}, BB = {bb[bj][e], bb[bj][e + 1]};
                        const f32x2 U0 = {acc[ai][bj][0][n][e], acc[ai][bj][0][n][e + 1]}, U1 = {acc[ai][bj][1][n][e], acc[ai][bj][1][n][e + 1]}, U2 = {acc[ai][bj][2][n][e], acc[ai][bj][2][n][e + 1]}, U3 = {acc[ai][bj][3][n][e], acc[ai][bj][3][n][e + 1]};
                        const f32x2 D3 = {dpp_shr1(A[e], U3.x), dpp_shr1(A[e + 1], U3.y)}, D2 = {dpp_shr1(B[e], U2.x), dpp_shr1(B[e + 1], U2.y)};
                        const f32x2 Y0 = __builtin_elementwise_fma(W0, D2, __builtin_elementwise_fma(W1, D3, __builtin_elementwise_fma(W2, U0, BB)));
                        const f32x2 Y1 = __builtin_elementwise_fma(W0, D3, __builtin_elementwise_fma(W1, U0, __builtin_elementwise_fma(W2, U1, BB)));
                        const f32x2 Y2 = __builtin_elementwise_fma(W0, U0, __builtin_elementwise_fma(W1, U1, __builtin_elementwise_fma(W2, U2, BB)));
                        const f32x2 Y3 = __builtin_elementwise_fma(W0, U1, __builtin_elementwise_fma(W1, U2, __builtin_elementwise_fma(W2, U3, BB)));
                        y[bj][0][e] = Y0.x; y[bj][0][e + 1] = Y0.y; y[bj][1][e] = Y1.x; y[bj][1][e + 1] = Y1.y; y[bj][2][e] = Y2.x; y[bj][2][e + 1] = Y2.y; y[bj][3][e] = Y3.x; y[bj][3][e + 1] = Y3.y; }
                }
                float nl2e = -1.4426950408889634f, one = 1.f; asm volatile("" : "+v"(nl2e), "+v"(one));
#pragma unroll
                for (int m = 0; m < 4; ++m) { f32x4 a;
#pragma unroll
                    for (int e = 0; e < 4; e += 2) {
                        const f32x2 G = {y[0][m][e], y[0][m][e + 1]}, V = {y[1][m][e], y[1][m][e + 1]}; const f32x2 NG = G * (f32x2){nl2e, nl2e};
                        const f32x2 D = (f32x2){__builtin_amdgcn_exp2f(NG.x), __builtin_amdgcn_exp2f(NG.y)} + (f32x2){one, one};
                        const f32x2 R = (f32x2){__builtin_amdgcn_rcpf(D.x), __builtin_amdgcn_rcpf(D.y)}; const f32x2 O = (G * R) * V; a[e] = O.x; a[e + 1] = O.y; }
                    u32x2 w; w.x = cvt_pk_bf16(a[0], a[1]); w.y = cvt_pk_bf16(a[2], a[3]);
                    { bf16_t* p_ = arow; asm volatile("" : "+v"(p_));
                      *(__attribute__((address_space(1))) u32x2*)(p_ + (size_t)(ai * HALF + m) * DFFc + 4 * n) = w; } }
            }
        }
    }
};
}
#define GAS __attribute__((address_space(1)))
#define LAS __attribute__((address_space(3)))
typedef unsigned short bf16;
typedef unsigned v4u __attribute__((ext_vector_type(4)));
typedef float f32x4 __attribute__((ext_vector_type(4)));
typedef short bf16x8 __attribute__((ext_vector_type(8)));
typedef GAS unsigned gu32;
typedef GAS unsigned long long gu64;
#define RLX_AGENT __ATOMIC_RELAXED, __HIP_MEMORY_SCOPE_AGENT
#define LDS_WAIT() asm volatile("s_waitcnt lgkmcnt(0)" ::: "memory")
#define VM_WAIT() asm volatile("s_waitcnt vmcnt(0)" ::: "memory")
__device__ __forceinline__ unsigned long long rt() { return __builtin_amdgcn_s_memrealtime(); }
__device__ __forceinline__ unsigned f2bf(float f) { unsigned u = __builtin_bit_cast(unsigned, f); return (u + 0x7fffu + ((u >> 16) & 1u)) >> 16; }
__device__ __forceinline__ unsigned pk2(float lo, float hi) { return f2bf(lo) | (f2bf(hi) << 16); }

#define XB_TMO      128
#define XB_XCNT(j)  (256  + 64 * (j))
#define XB_XSUB(j)  (1280 + 64 * (j))
#define XB_XGEN(j)  (2304 + 64 * (j))
#define XB_TOP      3328
#define XB_TOPGEN   3392
#define XCD_BAR_WORDS 3456
#define XB_SPIN_CAP (1u << 23)

__device__ __forceinline__ unsigned xb_ld(unsigned* p)              { return __hip_atomic_load(p, __ATOMIC_RELAXED, __HIP_MEMORY_SCOPE_AGENT); }
__device__ __forceinline__ unsigned xb_add(unsigned* p, unsigned v) { return __hip_atomic_fetch_add(p, v, __ATOMIC_RELAXED, __HIP_MEMORY_SCOPE_AGENT); }
__device__ __forceinline__ unsigned xb_xcc_id() { return (unsigned)__builtin_amdgcn_s_getreg((3 << 11) | 20) & 0xFu; }
#define XB_SPIN(cond, bar) do { unsigned _sp = 0; while (cond) { __builtin_amdgcn_s_sleep(1); \
    if ((++_sp & 255u) == 0u) { if (xb_ld(&(bar)[XB_TMO])) break; if (_sp > XB_SPIN_CAP) { atomicAdd(&(bar)[XB_TMO], 1u); break; } } } } while (0)

struct XcdBarrier {
    unsigned* bar; unsigned x;
    volatile LAS unsigned* st;
};

__device__ __forceinline__ XcdBarrier xcd_barrier_post(unsigned* bar, volatile LAS unsigned* st) {
    XcdBarrier b; b.bar = bar; b.x = xb_xcc_id(); b.st = st;
    if (threadIdx.x == 0) (void)xb_add(&bar[XB_XCNT(b.x)], 1u);
    return b;
}
__device__ __forceinline__ void xcd_barrier_complete(unsigned* bar, unsigned x, unsigned& nloc, unsigned& nx) {
    const unsigned G = gridDim.x * gridDim.y * gridDim.z;
    unsigned sum, cnt, mine, sp = 0u;
    for (;;) {
        sum = 0u; cnt = 0u; mine = 0u;
#pragma unroll
        for (unsigned j = 0; j < 16; ++j) { const unsigned c = xb_ld(&bar[XB_XCNT(j)]); sum += c; cnt += (c > 0u) ? 1u : 0u; mine = (j == x) ? c : mine; }
        if (sum == G) break;
        __builtin_amdgcn_s_sleep(1);
        if ((++sp & 255u) == 0u) { if (xb_ld(&bar[XB_TMO])) break; if (sp > XB_SPIN_CAP) { atomicAdd(&bar[XB_TMO], 1u); break; } }
    }
    nloc = mine > 0u ? mine : 1u; nx = cnt > 0u ? cnt : 1u;
}

__device__ __forceinline__ void xcd_barrier(const XcdBarrier& b) {
    asm volatile("s_waitcnt vmcnt(0)" ::: "memory");
    __syncthreads();
    if (threadIdx.x == 0) {
        unsigned* bar = b.bar;
        __builtin_amdgcn_s_waitcnt(0);
        unsigned nloc = b.st[0], nx = b.st[1];
        if (nloc == 0u) { xcd_barrier_complete(bar, b.x, nloc, nx); b.st[0] = nloc; b.st[1] = nx; }
        const unsigned old = xb_add(&bar[XB_XSUB(b.x)], 1u);
        const unsigned gen = old / nloc;
        if (old + 1u == (gen + 1u) * nloc) {
            __builtin_amdgcn_fence(__ATOMIC_RELEASE, "agent");
            asm volatile("s_waitcnt vmcnt(0)" ::: "memory");
            const unsigned og = xb_add(&bar[XB_TOP], 1u);
            const unsigned tg = og / nx;
            if (og + 1u == (tg + 1u) * nx) xb_add(&bar[XB_TOPGEN], 1u);
            else XB_SPIN(xb_ld(&bar[XB_TOPGEN]) == tg, bar);
            __builtin_amdgcn_fence(__ATOMIC_ACQUIRE, "agent");
            xb_add(&bar[XB_XGEN(b.x)], 1u);
            asm volatile("s_waitcnt vmcnt(0)" ::: "memory");
        } else {
            XB_SPIN(xb_ld(&bar[XB_XGEN(b.x)]) == gen, bar);
            __builtin_amdgcn_fence(__ATOMIC_ACQUIRE, "agent");
            asm volatile("s_waitcnt vmcnt(0)" ::: "memory");
        }
    }
    __syncthreads();
}
#include <hip/hip_bf16.h>
#include <cmath>
namespace fox_body {
using bf16=__hip_bfloat16;
using bf16x8=__attribute__((ext_vector_type(8)))short;
using s16x4=__attribute__((ext_vector_type(4)))short;
using f32x16=__attribute__((ext_vector_type(16)))float;
using u32x4=__attribute__((ext_vector_type(4)))unsigned;
constexpr int BATCH=2,NHEAD=32,SEQ=8192,D=64,DMQ=6144,DMO=2048;
constexpr float SKIP_T=40.f;
constexpr int NW=8,QBLK=32,QB=QBLK*NW,KVBLK=64,NQB=SEQ/QB;
constexpr int ATTN_UNIT_ROWS=QB;
__device__ __forceinline__ int crow(int r,int hi){return (r&3)+8*(r>>2)+4*hi;}
#define SBAR() __builtin_amdgcn_sched_barrier(0)
__device__ __forceinline__ void cmask(f32x16&p0,f32x16&p1,int jb,int qrel,int hi){
  const float NEG=-INFINITY; int kb=64*jb+4*hi;
  #pragma unroll
  for(int r=0;r<16;++r){int kv=kb+(r&3)+8*(r>>2); if(kv>qrel)p0[r]=NEG; if(kv+32>qrel)p1[r]=NEG;}
}

constexpr int NSLOT=3, SLOTB=8192;
constexpr int LDS_K=0, LDS_V=NSLOT*SLOTB, LDS_WS=2*NSLOT*SLOTB, LDS_OST=LDS_WS+NW*64*4, LDS_FROW=LDS_OST+NW*4096+2048, LDS_BYTES=LDS_FROW+SEQ*4;
constexpr float C2=0.125f*1.4426950408889634f;
__device__ __forceinline__ void glds16(const void*gsrc,unsigned lds_dst){unsigned keep;
  asm volatile("s_mov_b32 %0, m0\n\ts_mov_b32 m0, %2\n\ts_nop 0\n\tglobal_load_lds_dwordx4 %1, off\n\ts_mov_b32 m0, %0":"=&s"(keep):"v"(gsrc),"s"(lds_dst):"memory");}
__device__ __forceinline__ float max3f(float a,float b,float c){float r;asm("v_max3_f32 %0, %1, %2, %3":"=v"(r):"v"(a),"v"(b),"v"(c));return r;}
__device__ __forceinline__ float max2f(float a,float b){float r;asm("v_max_f32_e32 %0, %1, %2":"=v"(r):"v"(a),"v"(b));return r;}
__device__ __forceinline__ float fadd_s(float a,float b){float r;asm("v_add_f32_e32 %0, %1, %2":"=v"(r):"v"(a),"v"(b));return r;}
__device__ __forceinline__ float fsub_s(float a,float b){float r;asm("v_sub_f32_e32 %0, %1, %2":"=v"(r):"v"(a),"v"(b));return r;}
typedef float f32x2_t __attribute__((ext_vector_type(2))); typedef __bf16 bf16x2_t __attribute__((ext_vector_type(2)));
__device__ __forceinline__ unsigned cvtpk_s(float lo,float hi){f32x2_t v={lo,hi};bf16x2_t b=__builtin_convertvector(v,bf16x2_t);return __builtin_bit_cast(unsigned,b);}
#define WAIT_BAR(N) asm volatile("s_waitcnt vmcnt(" #N ") lgkmcnt(0)\n\ts_barrier":::"memory")

__device__ __forceinline__ void qkt(f32x16&p0,f32x16&p1,const char*Kslot,const bf16x8*qr,int r32,int hi){
  const char*kb=Kslot+hi*1024+r32*16;
  #pragma unroll
  for(int d0=0;d0<4;++d0){
    const bf16x8 b0=*reinterpret_cast<const bf16x8*>(kb+d0*2048);
    const bf16x8 b1=*reinterpret_cast<const bf16x8*>(kb+d0*2048+512);
    p0=__builtin_amdgcn_mfma_f32_32x32x16_bf16(b0,qr[d0],p0,0,0,0);p1=__builtin_amdgcn_mfma_f32_32x32x16_bf16(b1,qr[d0],p1,0,0,0);}
}
typedef __attribute__((address_space(3))) const char* lds_cptr;
typedef short v4i16_t __attribute__((ext_vector_type(4)));
__device__ __forceinline__ void kload8(bf16x8*kf,lds_cptr kp){
  kf[0]=*(const __attribute__((address_space(3))) bf16x8*)(kp);      kf[1]=*(const __attribute__((address_space(3))) bf16x8*)(kp+512);
  kf[2]=*(const __attribute__((address_space(3))) bf16x8*)(kp+2048); kf[3]=*(const __attribute__((address_space(3))) bf16x8*)(kp+2560);
  kf[4]=*(const __attribute__((address_space(3))) bf16x8*)(kp+4096); kf[5]=*(const __attribute__((address_space(3))) bf16x8*)(kp+4608);
  kf[6]=*(const __attribute__((address_space(3))) bf16x8*)(kp+6144); kf[7]=*(const __attribute__((address_space(3))) bf16x8*)(kp+6656);
}
__device__ __forceinline__ void kload2(bf16x8*kf,lds_cptr kp,int j){ kf[2*j]=*(const __attribute__((address_space(3))) bf16x8*)(kp+j*2048); kf[2*j+1]=*(const __attribute__((address_space(3))) bf16x8*)(kp+j*2048+512); }
__device__ __forceinline__ s16x4 vtr(lds_cptr p){ return __builtin_bit_cast(s16x4,__builtin_amdgcn_ds_read_tr16_b64_v4i16((__attribute__((address_space(3))) v4i16_t*)p)); }
__device__ __forceinline__ float rowmax(const f32x16&p0,const f32x16&p1){
  float a=max3f(p0[0],p0[1],p1[0]),b=max3f(p0[2],p0[3],p1[1]);a=max3f(a,p1[2],p1[3]);
  #pragma unroll
  for(int r=4;r<16;r+=4){a=max3f(a,p0[r],p0[r+1]);b=max3f(b,p0[r+2],p0[r+3]);a=max3f(a,p1[r],p1[r+1]);b=max3f(b,p1[r+2],p1[r+3]);}
  const float m=max2f(a,b);
  auto rr=__builtin_amdgcn_permlane32_swap(__float_as_uint(m),__float_as_uint(m),false,false);
  return max2f(__uint_as_float(rr[0]),__uint_as_float(rr[1]));
}
__device__ __forceinline__ void pv2(f32x16*o,int vb,const int ks0,bf16x8 pa0,bf16x8 pa1){
  s16x4 lo[2][2],hi[2][2];
  #pragma unroll
  for(int d0=0;d0<2;++d0)
    #pragma unroll
    for(int ks=0;ks<2;++ks){
      if(ks0==0){ asm volatile("ds_read_b64_tr_b16 %0,%1 offset:%c2":"=&v"(lo[d0][ks]):"v"(vb),"i"(d0*4096+ks*1024):"memory"); asm volatile("ds_read_b64_tr_b16 %0,%1 offset:%c2":"=&v"(hi[d0][ks]):"v"(vb),"i"(d0*4096+ks*1024+512):"memory"); }
      else      { asm volatile("ds_read_b64_tr_b16 %0,%1 offset:%c2":"=&v"(lo[d0][ks]):"v"(vb),"i"(d0*4096+(ks+2)*1024):"memory"); asm volatile("ds_read_b64_tr_b16 %0,%1 offset:%c2":"=&v"(hi[d0][ks]):"v"(vb),"i"(d0*4096+(ks+2)*1024+512):"memory"); } }
  asm volatile("s_waitcnt lgkmcnt(0)":::"memory");SBAR();
  #pragma unroll
  for(int d0=0;d0<2;++d0){
    o[d0]=__builtin_amdgcn_mfma_f32_32x32x16_bf16(pa0,(bf16x8){lo[d0][0][0],lo[d0][0][1],lo[d0][0][2],lo[d0][0][3],hi[d0][0][0],hi[d0][0][1],hi[d0][0][2],hi[d0][0][3]},o[d0],0,0,0);
    o[d0]=__builtin_amdgcn_mfma_f32_32x32x16_bf16(pa1,(bf16x8){lo[d0][1][0],lo[d0][1][1],lo[d0][1][2],lo[d0][1][3],hi[d0][1][0],hi[d0][1][1],hi[d0][1][2],hi[d0][1][3]},o[d0],0,0,0); }
}
__device__ __forceinline__ void pv(f32x16*o,int vb,bf16x8 pa0,bf16x8 pa1,bf16x8 pa2,bf16x8 pa3){
  #pragma unroll
  for(int d0=0;d0<2;++d0){s16x4 lo[4],hi[4];
    #pragma unroll
    for(int ks=0;ks<4;++ks){
      asm volatile("ds_read_b64_tr_b16 %0,%1 offset:%c2":"=&v"(lo[ks]):"v"(vb),"i"(d0*4096+ks*1024):"memory");
      asm volatile("ds_read_b64_tr_b16 %0,%1 offset:%c2":"=&v"(hi[ks]):"v"(vb),"i"(d0*4096+ks*1024+512):"memory");}
    asm volatile("s_waitcnt lgkmcnt(0)":::"memory");SBAR();
    #define PK(k) (bf16x8){lo[k][0],lo[k][1],lo[k][2],lo[k][3],hi[k][0],hi[k][1],hi[k][2],hi[k][3]}
    o[d0]=__builtin_amdgcn_mfma_f32_32x32x16_bf16(pa0,PK(0),o[d0],0,0,0);
    o[d0]=__builtin_amdgcn_mfma_f32_32x32x16_bf16(pa1,PK(1),o[d0],0,0,0);
    o[d0]=__builtin_amdgcn_mfma_f32_32x32x16_bf16(pa2,PK(2),o[d0],0,0,0);
    o[d0]=__builtin_amdgcn_mfma_f32_32x32x16_bf16(pa3,PK(3),o[d0],0,0,0);
    #undef PK
  }
}

#ifndef ATTN_STORE16
#define ATTN_STORE16(p,v) (*(u32x4*)(p)=(v))
#endif
template<int THRL> __device__ __forceinline__ void attn_unit(int b,int h,int qb,const bf16*Q,const bf16*__restrict__ K,const bf16*__restrict__ V,bf16*O,const float*__restrict__ Fg,const unsigned*__restrict__ qk2,char*shm,const int wv){
  int tid_=wv*64+lane_id_fresh(); const int tid=tid_,lane=tid&63,r32=lane&31,hi=lane>>5; const int wid=__builtin_amdgcn_readfirstlane(tid>>6);
  const long rowbase=(long)b*SEQ; const int q0=qb*QB;
  const bf16*Qw=Q+(rowbase+q0+wid*QBLK)*DMQ+h*D;
  const float* Fh=Fg+(long)(b*NHEAD+h)*SEQ;
  int t0=0;
  { const unsigned qa=qk2[(b*NHEAD+h)*4+0],qb2=qk2[(b*NHEAD+h)*4+1],ka=qk2[(b*NHEAD+h)*4+2],kb=qk2[(b*NHEAD+h)*4+3];
    const float S2=2.04f*sqrtf((__uint_as_float(qa)+__uint_as_float(qb2))*(__uint_as_float(ka)+__uint_as_float(kb)));
    const float thrF=Fh[q0]+(SKIP_T+S2)*0.6931471805599453f;
    const int NT0=(q0+QB)/KVBLK; const int ta=lane, tb=lane+64;
    const bool ca=(ta<NT0-4)&&(Fh[64*ta+63]>=thrF), cb=(tb<NT0-4)&&(Fh[64*tb+63]>=thrF);
    t0=__builtin_popcountll(__ballot(ca))+__builtin_popcountll(__ballot(cb)); t0&=~1; if(t0>NT0-4)t0=NT0-4; t0=__builtin_amdgcn_readfirstlane(t0); }
  const bf16*Kh=K+(rowbase+64*t0)*DMQ+h*D,*Vh=V+(rowbase+64*t0)*DMQ+h*D;
  const __attribute__((address_space(3))) char* shm3f=(__attribute__((address_space(3))) char*)shm; const unsigned lds0=(unsigned)(uintptr_t)shm;
  float*wsf=(float*)(shm+LDS_WS)+wid*64;
  const bf16*ksrc=Kh+(long)lane*DMQ+wid*8;
  const bf16*vsrc=Vh+(long)(16*(wid&3)+(lane>>2))*DMQ+(wid>>2)*32+(lane&3)*8;
  const unsigned kdst=lds0+LDS_K+wid*1024, vdst=lds0+LDS_V+wid*1024;
  #define DMA_K(t,slot) glds16(ksrc+(long)(t)*KVBLK*DMQ,(unsigned)__builtin_amdgcn_readfirstlane(kdst+(slot)))
  #define DMA_V(t,slot) glds16(vsrc+(long)(t)*KVBLK*DMQ,(unsigned)__builtin_amdgcn_readfirstlane(vdst+(slot)))
  const int vb0=(int)(lds0+LDS_V)+((lane>>4)&1)*32+(lane&3)*8+(4*hi+((lane&15)>>2))*64;
  const char*Kbase=shm+LDS_K; bf16x8 kf[8];
  const lds_cptr shm3=(lds_cptr)shm; const lds_cptr kp0=shm3+LDS_K+hi*1024+r32*16; const lds_cptr vp0=shm3+LDS_V+((lane>>4)&1)*32+(lane&3)*8+(4*hi+((lane&15)>>2))*64;
  const int NT=(q0+QB)/KVBLK-t0;
  { typedef float f32x4_t __attribute__((ext_vector_type(4))); const f32x4_t*fg=(const f32x4_t*)(Fh+64*t0); __attribute__((address_space(3))) f32x4_t*fl=(__attribute__((address_space(3))) f32x4_t*)(shm3f+LDS_FROW);
    for(int i=tid;i<(q0+QB-64*t0)/4;i+=NW*64){f32x4_t v=fg[i]; fl[i]=v*1.4426950408889634f;} }
  DMA_K(0,0);DMA_V(0,0);DMA_K(1,SLOTB);
  bf16x8 qr[4];
  #pragma unroll
  for(int d0=0;d0<4;++d0)qr[d0]=*reinterpret_cast<const bf16x8*>(&Qw[(long)r32*DMQ+d0*16+hi*8]);
  float mhat=0.f,l_reg=0.f;f32x16 o[2];o[0]=f32x16{};o[1]=f32x16{};
  typedef __attribute__((address_space(3))) const float* lds_fptr; typedef float f32x4_t __attribute__((ext_vector_type(4))); typedef float f32x2_t __attribute__((ext_vector_type(2)));
  const lds_fptr frow=(lds_fptr)(shm3f+LDS_FROW)+4*hi;
  float fq2=0.f, nb=0.f;
  #define FPK(lo_,hi_,src_) asm("v_pk_add_f32 %0, %2, %3 neg_lo:[0,1] neg_hi:[0,1]\n\tv_pk_add_f32 %1, %2, %4 neg_lo:[0,1] neg_hi:[0,1]" : "=&v"(lo_), "=&v"(hi_) : "v"(n2_), "v"(__builtin_shufflevector(src_,src_,0,1)), "v"(__builtin_shufflevector(src_,src_,2,3)))
  #define FINIT(C0,C1,t) do{ const lds_fptr fp_=frow+(t)*64; const f32x2_t n2_={nb,nb}; f32x2_t c_[16]; \
      _Pragma("unroll") for(int g_=0;g_<4;++g_){ const f32x4_t a_=*(const __attribute__((address_space(3))) f32x4_t*)(fp_+8*g_), b_=*(const __attribute__((address_space(3))) f32x4_t*)(fp_+32+8*g_); \
        FPK(c_[2*g_],c_[2*g_+1],a_); FPK(c_[8+2*g_],c_[8+2*g_+1],b_); } \
      C0=__builtin_shufflevector(__builtin_shufflevector(__builtin_shufflevector(c_[0],c_[1],0,1,2,3),__builtin_shufflevector(c_[2],c_[3],0,1,2,3),0,1,2,3,4,5,6,7),__builtin_shufflevector(__builtin_shufflevector(c_[4],c_[5],0,1,2,3),__builtin_shufflevector(c_[6],c_[7],0,1,2,3),0,1,2,3,4,5,6,7),0,1,2,3,4,5,6,7,8,9,10,11,12,13,14,15); \
      C1=__builtin_shufflevector(__builtin_shufflevector(__builtin_shufflevector(c_[8],c_[9],0,1,2,3),__builtin_shufflevector(c_[10],c_[11],0,1,2,3),0,1,2,3,4,5,6,7),__builtin_shufflevector(__builtin_shufflevector(c_[12],c_[13],0,1,2,3),__builtin_shufflevector(c_[14],c_[15],0,1,2,3),0,1,2,3,4,5,6,7),0,1,2,3,4,5,6,7,8,9,10,11,12,13,14,15); }while(0)
  const int qrel=wid*QBLK+r32;
  #define CMASK(P0,P1,t) do{int jb_=(t)-(NT-4); if(jb_>=0)cmask(P0,P1,jb_,qrel,hi);}while(0)
  bool resc=false;
  #define START(P0,P1) do{ const float rm=rowmax(P0,P1); resc=false; \
    { const float dl=rm; mhat=fadd_s(mhat,dl); \
      _Pragma("unroll") for(int r=0;r<16;++r){P0[r]=fsub_s(P0[r],dl);P1[r]=fsub_s(P1[r],dl);} \
      nb=fq2-mhat; } \
    _Pragma("unroll") for(int r=0;r<16;++r)P0[r]=__builtin_amdgcn_exp2f(P0[r]); }while(0)
  #define RESC() do{ if(resc){ asm volatile("s_waitcnt lgkmcnt(0)":::"memory"); \
      _Pragma("unroll") for(int d_=0;d_<2;++d_) _Pragma("unroll") for(int r=0;r<16;++r)o[d_][r]*=wsf[crow(r,hi)]; } }while(0)
  f32x16 pA0,pA1,pB0,pB1;
  int sl_prev=0,sl_cur=0,sl_next=SLOTB;
  #define ROT() do{sl_prev=sl_cur;sl_cur=sl_next;sl_next=(sl_next==(NSLOT-1)*SLOTB)?0:sl_next+SLOTB;}while(0)
  DMA_K(2,2*SLOTB);
  WAIT_BAR(3);
  fq2=((lds_fptr)(shm3f+LDS_FROW))[q0-64*t0+wid*QBLK+r32]; nb=fq2;
  FINIT(pA0,pA1,0);
  qkt(pA0,pA1,Kbase,qr,r32,hi);asm volatile("s_nop 15\n\ts_nop 7":"+v"(pA0),"+v"(pA1));CMASK(pA0,pA1,0);
  START(pA0,pA1);
  _Pragma("unroll") for(int r=0;r<16;++r)pA1[r]=__builtin_amdgcn_exp2f(pA1[r]);
  WAIT_BAR(0);
  DMA_K(3,0);DMA_V(1,SLOTB);
  ROT();
  kload8(kf,kp0+sl_cur);
  WAIT_BAR(2);
  s16x4 vlo[8],vhi[8]; u32x4 pw0,pw1,pw2,pw3;
  #define PKW(P,B) cvtpk_s(P[B],P[B+1])
  #define PAF(k) __builtin_bit_cast(bf16x8,pw##k)
  #define VFR(i) (bf16x8){vlo[i][0],vlo[i][1],vlo[i][2],vlo[i][3],vhi[i][0],vhi[i][1],vhi[i][2],vhi[i][3]}
  #define PIN(x) asm volatile("":"+v"(x))
  #define MX3(a,b,c) __builtin_fmaxf(__builtin_fmaxf((a),(b)),(c))
  #define SPK(A0,A1) asm volatile("v_pk_add_f32 %0, %0, %1" : "+v"(sacc) : "v"((f32x2_t){A0,A1}))
  #define GAPA(MF,A0,A1,A2,A3,W0,W1,PW) do{ MF; SPK(A0,A1); SPK(A2,A3); W0; W1; PIN(PW); SBAR(); }while(0)
  #define GAPA1(MF,A0,A1,W0,W1,PW) do{ MF; SPK(A0,A1); W0; W1; PIN(PW); SBAR(); }while(0)
  #define EX(v) __builtin_amdgcn_exp2f(v)
  #define GAPB(MF,X,B) do{ MF; X[B]=EX(X[B]); X[B+1]=EX(X[B+1]); X[B+2]=EX(X[B+2]); X[B+3]=EX(X[B+3]); PIN(X); SBAR(); }while(0)
  #define VRD(i) do{ vlo[i]=vtr(vp_+(((i)>>2)*4096+((i)&3)*1024)); vhi[i]=vtr(vp_+(((i)>>2)*4096+((i)&3)*1024+512)); }while(0)
  #define KRD(G,j) do{ if(G){ kload2(kf,kp0+sl_next,j); SBAR(); } }while(0)
  #define STEP(C0,C1,P0,P1,t,GK,GV,GL) do{ SBAR(); \
    const lds_cptr vp_=vp0+sl_prev; \
    FINIT(C0,C1,t); SBAR(); \
    VRD(0); SBAR(); f32x2_t sacc={P0[0],P0[1]}; \
    GAPA(C0=__builtin_amdgcn_mfma_f32_32x32x16_bf16(kf[0],qr[0],C0,0,0,0), P0[2],P0[3],P0[4],P0[5],     pw0[0]=PKW(P0,0), pw0[1]=PKW(P0,2), pw0); \
    VRD(4); SBAR(); GAPA(C1=__builtin_amdgcn_mfma_f32_32x32x16_bf16(kf[1],qr[0],C1,0,0,0), P0[6],P0[7],P0[8],P0[9],     pw0[2]=PKW(P0,4), pw0[3]=PKW(P0,6), pw0); \
    VRD(1); SBAR(); GAPA(C0=__builtin_amdgcn_mfma_f32_32x32x16_bf16(kf[2],qr[1],C0,0,0,0),   P0[10],P0[11],P0[12],P0[13], pw1[0]=PKW(P0,8), pw1[1]=PKW(P0,10), pw1); \
    VRD(5); SBAR(); GAPA(C1=__builtin_amdgcn_mfma_f32_32x32x16_bf16(kf[3],qr[1],C1,0,0,0),   P0[14],P0[15],P1[0],P1[1],   pw1[2]=PKW(P0,12),pw1[3]=PKW(P0,14), pw1); \
    VRD(2); SBAR(); GAPA(C0=__builtin_amdgcn_mfma_f32_32x32x16_bf16(kf[4],qr[2],C0,0,0,0),   P1[2],P1[3],P1[4],P1[5],     pw2[0]=PKW(P1,0), pw2[1]=PKW(P1,2), pw2); \
    VRD(6); SBAR(); GAPA(C1=__builtin_amdgcn_mfma_f32_32x32x16_bf16(kf[5],qr[2],C1,0,0,0),   P1[6],P1[7],P1[8],P1[9],     pw2[2]=PKW(P1,4), pw2[3]=PKW(P1,6), pw2); \
    VRD(3); SBAR(); GAPA(C0=__builtin_amdgcn_mfma_f32_32x32x16_bf16(kf[6],qr[3],C0,0,0,0),   P1[10],P1[11],P1[12],P1[13], pw3[0]=PKW(P1,8), pw3[1]=PKW(P1,10), pw3); \
    VRD(7); SBAR(); GAPA1(C1=__builtin_amdgcn_mfma_f32_32x32x16_bf16(kf[7],qr[3],C1,0,0,0),  P1[14],P1[15],               pw3[2]=PKW(P1,12),pw3[3]=PKW(P1,14), pw3); \
    l_reg+=sacc.x+sacc.y; \
    if(GK){DMA_K((t)+3,sl_cur);} if(GV){DMA_V((t)+1,sl_next);} \
    CMASK(C0,C1,t); \
    { float a=MX3(C0[0],C0[1],C1[0]),b=MX3(C0[2],C0[3],C1[1]); a=MX3(a,C1[2],C1[3]); \
      _Pragma("unroll") for(int r=4;r<16;r+=4){a=MX3(a,C0[r],C0[r+1]);b=MX3(b,C0[r+2],C0[r+3]);a=MX3(a,C1[r],C1[r+1]);b=MX3(b,C1[r+2],C1[r+3]);} \
      float rm=__builtin_fmaxf(a,b); { auto rr=__builtin_amdgcn_permlane32_swap(__float_as_uint(rm),__float_as_uint(rm),false,false); rm=__builtin_fmaxf(__uint_as_float(rr[0]),__uint_as_float(rr[1])); } \
      resc=false; \
      if(__builtin_expect(__any(rm>(float)THRL),0)){ const float dl=__builtin_fmaxf(rm,0.f); mhat+=dl; \
        _Pragma("unroll") for(int r=0;r<16;++r){C0[r]-=dl;C1[r]-=dl;} \
        nb=fq2-mhat; \
        const float f=__builtin_amdgcn_exp2f(-dl); l_reg*=f; if(hi==0)wsf[r32]=f; resc=true; } } \
    SBAR(); \
    GAPB(o[0]=__builtin_amdgcn_mfma_f32_32x32x16_bf16(PAF(0),VFR(0),o[0],0,0,0), C0,0); \
    GAPB(o[1]=__builtin_amdgcn_mfma_f32_32x32x16_bf16(PAF(0),VFR(4),o[1],0,0,0), C0,4); \
    KRD(GL,0); GAPB(o[0]=__builtin_amdgcn_mfma_f32_32x32x16_bf16(PAF(1),VFR(1),o[0],0,0,0), C0,8); \
    KRD(GL,1); GAPB(o[1]=__builtin_amdgcn_mfma_f32_32x32x16_bf16(PAF(1),VFR(5),o[1],0,0,0), C0,12); \
    KRD(GL,2); GAPB(o[0]=__builtin_amdgcn_mfma_f32_32x32x16_bf16(PAF(2),VFR(2),o[0],0,0,0), C1,0); \
    KRD(GL,3); GAPB(o[1]=__builtin_amdgcn_mfma_f32_32x32x16_bf16(PAF(2),VFR(6),o[1],0,0,0), C1,4); \
    GAPB(o[0]=__builtin_amdgcn_mfma_f32_32x32x16_bf16(PAF(3),VFR(3),o[0],0,0,0), C1,8); \
    GAPB(o[1]=__builtin_amdgcn_mfma_f32_32x32x16_bf16(PAF(3),VFR(7),o[1],0,0,0), C1,12); \
    }while(0)
  int t=1;
  #undef CMASK
  #define CMASK(P0,P1,t) do{}while(0)
  for(;t+5<NT;t+=2){
    STEP(pB0,pB1,pA0,pA1,t,true,true,true);     WAIT_BAR(2); RESC(); ROT();
    STEP(pA0,pA1,pB0,pB1,t+1,true,true,true);   WAIT_BAR(2); RESC(); ROT();
  }
  #undef CMASK
  #define CMASK(P0,P1,t) do{int jb_=(t)-(NT-4); if(jb_>=0)cmask(P0,P1,jb_,qrel,hi);}while(0)
  #define ENDW(tt) do{ if((tt)+3<NT){WAIT_BAR(2);} else if((tt)+2<NT){WAIT_BAR(1);} else {WAIT_BAR(0);} }while(0)
  for(;t+1<NT;t+=2){
    STEP(pB0,pB1,pA0,pA1,t,(t+3<NT),(t+1<NT),(t+1<NT));       ENDW(t);   RESC(); ROT();
    STEP(pA0,pA1,pB0,pB1,t+1,(t+4<NT),(t+2<NT),(t+2<NT));     ENDW(t+1); RESC(); ROT();
  }
  STEP(pB0,pB1,pA0,pA1,NT-1,false,false,false); RESC();
  { float sacc=pB0[0]+pB0[1]; _Pragma("unroll") for(int r=2;r<16;++r)sacc+=pB0[r]; _Pragma("unroll") for(int r=0;r<16;++r)sacc+=pB1[r]; l_reg+=sacc;
    pw0=(u32x4){PKW(pB0,0),PKW(pB0,2),PKW(pB0,4),PKW(pB0,6)};pw1=(u32x4){PKW(pB0,8),PKW(pB0,10),PKW(pB0,12),PKW(pB0,14)};pw2=(u32x4){PKW(pB1,0),PKW(pB1,2),PKW(pB1,4),PKW(pB1,6)};pw3=(u32x4){PKW(pB1,8),PKW(pB1,10),PKW(pB1,12),PKW(pB1,14)};
    SBAR(); pv(o,vb0+sl_cur,PAF(0),PAF(1),PAF(2),PAF(3)); }
  #undef PKW
  #undef PAF
  #undef VFR
  #undef PIN
  #undef MX3
  #undef GAPA
  #undef GAPB
  #undef EX
  #undef VRD
  #undef KRD
  #undef STEP
  #undef ENDW
  {auto rr=__builtin_amdgcn_permlane32_swap(__float_as_uint(l_reg),__float_as_uint(l_reg),false,false);l_reg=__uint_as_float(rr[0])+__uint_as_float(rr[1]);}
  if(hi==0)wsf[32+r32]=l_reg;asm volatile("s_waitcnt lgkmcnt(0)":::"memory");
  float rli[16];
  #pragma unroll
  for(int r=0;r<16;++r)rli[r]=__builtin_amdgcn_rcpf(wsf[32+crow(r,hi)]);
  bf16*Ow=O+(rowbase+q0+wid*QBLK)*DMO+h*D;
  { bf16*stg=(bf16*)(shm+LDS_OST)+wid*2048;
    #pragma unroll
    for(int r=0;r<16;++r){const int orow=crow(r,hi);
      #pragma unroll
      for(int d0=0;d0<2;++d0)stg[orow*64+d0*32+r32]=__float2bfloat16(o[d0][r]*rli[r]);}
    asm volatile("s_waitcnt lgkmcnt(0)":::"memory");
    #pragma unroll
    for(int i=0;i<4;++i){const int row=i*8+(lane>>3),ch=lane&7; const u32x4 v=*(const u32x4*)(stg+row*64+ch*8); ATTN_STORE16(Ow+(long)row*DMO+ch*8,v);} }
  asm volatile("s_waitcnt lgkmcnt(0)\n\ts_barrier":::"memory");
  #undef DMA_K
  #undef DMA_V
  #undef CMASK
  #undef START
  #undef RESC
  #undef FINIT
  #undef ROT
}
constexpr int LDS_QSLOT=LDS_BYTES, ATTN_LDS_BYTES=LDS_BYTES+64;
struct AttnTensors { const bf16* Q; const bf16* K; const bf16* V; bf16* O; const float* F; const unsigned* qk2; unsigned* queue; };
struct AttnUnit { int bh; int qb; };
struct StaticOrder {
  int vcu, G;
  __device__ __forceinline__ explicit StaticOrder(int grid,int block):vcu((grid%8==0)?(block%8)*(grid/8)+block/8:block),G(grid){}
  __device__ __forceinline__ bool next(int i,AttnUnit&u)const{
    if(G==256){ if(i>=8)return false; const int s=vcu&3, o=8*(i>>1); u.bh=vcu>>2; u.qb=(i&1)?o+7-s:o+s; return true; }
    const int idx=i*G+vcu; if(idx>=BATCH*NHEAD*NQB)return false; u.bh=idx/NQB; u.qb=NQB-1-idx%NQB; return true; }
  __device__ __forceinline__ void a_ready(const AttnUnit&)const{}
  __device__ __forceinline__ void done(const AttnUnit&)const{}
};
template<int THRL=8> __device__ __forceinline__ void attn_phase(char*lds,const AttnTensors&T,const int wv){
  const int tid=wv*64+lane_id_fresh();
  volatile __attribute__((address_space(3))) int* qs=(volatile __attribute__((address_space(3))) int*)((__attribute__((address_space(3))) char*)lds+LDS_QSLOT);
  int nxt=0;
  if(tid==0){ nxt=(int)__hip_atomic_fetch_add(T.queue,1u,__ATOMIC_RELAXED,__HIP_MEMORY_SCOPE_AGENT); qs[0]=nxt; }
  asm volatile("s_waitcnt vmcnt(0) lgkmcnt(0)\n\ts_barrier":::"memory");
  int cur=qs[0]; int par=1;
  while(cur<BATCH*NHEAD*NQB){
    if(tid==0) nxt=(int)__hip_atomic_fetch_add(T.queue,1u,__ATOMIC_RELAXED,__HIP_MEMORY_SCOPE_AGENT);
    const int qb=NQB-1-cur/(BATCH*NHEAD), bh=cur%(BATCH*NHEAD);
    attn_unit<THRL>(bh/NHEAD,bh%NHEAD,qb,T.Q,T.K,T.V,T.O,T.F,T.qk2,lds,wv);
    if(tid==0) qs[par]=nxt;
    asm volatile("s_waitcnt vmcnt(0) lgkmcnt(0)\n\ts_barrier":::"memory");
    cur=qs[par]; par^=1;
  }
}

constexpr int SWA_SET=2*NSLOT*SLOTB;
constexpr int SWA_WS=2*SWA_SET, SWA_OST=SWA_WS+NW*64*4, SWA_LDS_BYTES=SWA_OST+NW*4096;
__device__ __forceinline__ void swa_issue(int u,const bf16*Y,unsigned lds_set,int lane,int wid){
  constexpr int PQ=2560; const int q0=(u%(SEQ/64))*64, hk=(u/(SEQ/64))&3, b=u/(4*(SEQ/64)); const long rowbase=(long)b*SEQ;
  const bf16*Kh=Y+rowbase*PQ+2048+hk*64,*Vh=Y+rowbase*PQ+2304+hk*64;
  #pragma unroll
  for(int j=0;j<3;++j){ int tr0=q0-128+64*j; if(tr0<0)tr0=0;
    glds16(Kh+(long)(tr0+lane)*PQ+wid*8,(unsigned)__builtin_amdgcn_readfirstlane(lds_set+LDS_K+j*SLOTB+wid*1024));
    glds16(Vh+(long)(tr0+16*(wid&3)+(lane>>2))*PQ+(wid>>2)*32+(lane&3)*8,(unsigned)__builtin_amdgcn_readfirstlane(lds_set+LDS_V+j*SLOTB+wid*1024)); }
}
__device__ __forceinline__ float swa_max3(float a,float b,float c){ float r; asm("v_max3_f32 %0, %1, %2, %3":"=v"(r):"v"(a),"v"(b),"v"(c)); return r; }
__device__ __forceinline__ void swa_unit(int u,int unext,int set,const bf16*Y,const float*__restrict__ sinks,bf16*O,char*shm,const int wv,unsigned*queue,int&tkt){
  int tid_=wv*64+lane_id_fresh(); const int tid=tid_,lane=tid&63,r32=lane&31,hi=lane>>5; const int wid=__builtin_amdgcn_readfirstlane(tid>>6);
  constexpr int PQ=2560;
  const int q0=(u%(SEQ/64))*64, hk=(u/(SEQ/64))&3, b=u/(4*(SEQ/64));
  const long rowbase=(long)b*SEQ;
  const unsigned lds0=(unsigned)(uintptr_t)shm;
  float*wsf=(float*)(shm+SWA_WS)+wid*64;
  const int qh=hk*8+wid;
  const float sink2=sinks[qh]*1.4426950408889634f;
  bf16x8 qr[4],qn[4];
  { const bf16*Qw=Y+(rowbase+q0)*PQ+qh*64;
    #pragma unroll
    for(int d0=0;d0<4;++d0){qr[d0]=*reinterpret_cast<const bf16x8*>(&Qw[(long)r32*PQ+d0*16+hi*8]);qn[d0]=*reinterpret_cast<const bf16x8*>(&Qw[(long)(32+r32)*PQ+d0*16+hi*8]);} }
  asm volatile("s_waitcnt vmcnt(0) lgkmcnt(0)\n\ts_barrier":::"memory");
  if(tid==0) tkt=(int)__hip_atomic_fetch_add(queue,1u,__ATOMIC_RELAXED,__HIP_MEMORY_SCOPE_AGENT);
  if(unext>=0) swa_issue(unext,Y,lds0+(set^1)*SWA_SET,lane,wid);
  const char*Kbase=shm+set*SWA_SET+LDS_K;
  const int vb0=(int)(lds0+set*SWA_SET+LDS_V)+((lane>>4)&1)*32+(lane&3)*8+(4*hi+((lane&15)>>2))*64;
  const float NEG=-INFINITY;
  const bool fast=(q0>=128);
  f32x16 MC,MO;
  #pragma unroll
  for(int r=0;r<16;++r){ const bool c=((r&3)+8*(r>>2)+4*hi)<=r32; MC[r]=c?0.f:NEG; MO[r]=c?NEG:0.f; }
  #pragma unroll 1
  for(int sb=0;sb<2;++sb){
    const int t=q0+32*sb+r32;
    f32x16 p[3][2];
    #define DEAD(j,x) (((j)==2&&(x)==1&&sb==0)||((j)==0&&(x)==0&&sb==1))
    #pragma unroll
    for(int j=0;j<3;++j){ const char*kb_=Kbase+j*SLOTB+hi*1024+r32*16;
      #pragma unroll
      for(int x=0;x<2;++x){ p[j][x]=f32x16{}; if(DEAD(j,x))continue;
        const bf16x8 k0_=*reinterpret_cast<const bf16x8*>(kb_+x*512);
        if(fast&&j==2&&x==sb) p[j][x]=__builtin_amdgcn_mfma_f32_32x32x16_bf16(k0_,qr[0],MC,0,0,0);
        else if(fast&&j==0&&x==sb) p[j][x]=__builtin_amdgcn_mfma_f32_32x32x16_bf16(k0_,qr[0],MO,0,0,0);
        else p[j][x]=__builtin_amdgcn_mfma_f32_32x32x16_bf16(k0_,qr[0],p[j][x],0,0,0);
        #pragma unroll
        for(int d0=1;d0<4;++d0) p[j][x]=__builtin_amdgcn_mfma_f32_32x32x16_bf16(*reinterpret_cast<const bf16x8*>(kb_+d0*2048+x*512),qr[d0],p[j][x],0,0,0); } }
    #pragma unroll
    for(int d0=0;d0<4;++d0)qr[d0]=qn[d0];
    SBAR(); asm volatile("s_nop 15\n\ts_nop 7"); SBAR();
    float m=sink2;
    const int lo=(t>127)?t-127:0;
    #pragma unroll
    for(int j=0;j<3;++j){ const int kb=q0-128+64*j+4*hi; const int dlim=(j<2)?lo-kb:t-kb;
      #pragma unroll
      for(int x=0;x<2;++x){ if(DEAD(j,x))continue;
        if(fast||(j==1&&q0>=64)){
          #pragma unroll
          for(int r=0;r<16;r+=2) m=swa_max3(m,p[j][x][r],p[j][x][r+1]);
          continue; }
        #pragma unroll
        for(int r=0;r<16;++r){ const int kr=(r&3)+8*(r>>2)+32*x; const bool ok=(j<2)?(kr>=dlim):(kr<=dlim); const float v=ok?p[j][x][r]:NEG; p[j][x][r]=v; if(r&1) m=swa_max3(m,p[j][x][r-1],v); } } }
    { auto rr=__builtin_amdgcn_permlane32_swap(__float_as_uint(m),__float_as_uint(m),false,false); m=__builtin_fmaxf(__uint_as_float(rr[0]),__uint_as_float(rr[1])); }
    float l;
    { typedef float f32x2 __attribute__((ext_vector_type(2)));
      f32x2 l2={0.f,0.f}; const f32x2 M2={m,m};
      #pragma unroll
      for(int j=0;j<3;++j)
        #pragma unroll
        for(int x=0;x<2;++x){ if(DEAD(j,x))continue;
          #pragma unroll
          for(int r=0;r<16;r+=2){ f32x2 X0=(f32x2){p[j][x][r],p[j][x][r+1]}-M2;
            X0=(f32x2){__builtin_amdgcn_exp2f(X0.x),__builtin_amdgcn_exp2f(X0.y)}; p[j][x][r]=X0.x; p[j][x][r+1]=X0.y; l2+=X0; } }
      l=l2.x+l2.y; }
    { auto rr=__builtin_amdgcn_permlane32_swap(__float_as_uint(l),__float_as_uint(l),false,false); l=__uint_as_float(rr[0])+__uint_as_float(rr[1]); }
    l+=__builtin_amdgcn_exp2f(sink2-m);
    f32x16 o[2]; o[0]=f32x16{}; o[1]=f32x16{};
    #pragma unroll
    for(int j=0;j<3;++j){
      #pragma unroll
      for(int x=0;x<2;++x){ if(DEAD(j,x))continue;
        u32x4 pwa,pwb;
        pwa=(u32x4){cvtpk_s(p[j][x][0],p[j][x][1]),cvtpk_s(p[j][x][2],p[j][x][3]),cvtpk_s(p[j][x][4],p[j][x][5]),cvtpk_s(p[j][x][6],p[j][x][7])};
        pwb=(u32x4){cvtpk_s(p[j][x][8],p[j][x][9]),cvtpk_s(p[j][x][10],p[j][x][11]),cvtpk_s(p[j][x][12],p[j][x][13]),cvtpk_s(p[j][x][14],p[j][x][15])};
        SBAR(); pv2(o,vb0+j*SLOTB,2*x,__builtin_bit_cast(bf16x8,pwa),__builtin_bit_cast(bf16x8,pwb)); } }
    #undef DEAD
    if(hi==0)wsf[32+r32]=__builtin_amdgcn_rcpf(l); asm volatile("s_waitcnt lgkmcnt(0)":::"memory");
    float rli[16];
    #pragma unroll
    for(int r=0;r<16;++r)rli[r]=wsf[32+crow(r,hi)];
    bf16*Ow=O+(rowbase+q0+32*sb)*DMO+qh*64;
    { bf16*stg=(bf16*)(shm+SWA_OST)+wid*2048;
      #pragma unroll
      for(int r=0;r<16;++r){const int orow=crow(r,hi);
        #pragma unroll
        for(int d0=0;d0<2;++d0)stg[orow*64+d0*32+r32]=__float2bfloat16(o[d0][r]*rli[r]);}
      asm volatile("s_waitcnt lgkmcnt(0)":::"memory");
      #pragma unroll
      for(int i=0;i<4;++i){const int row=i*8+(lane>>3),ch=lane&7; const u32x4 v=*(const u32x4*)(stg+row*64+ch*8); *(u32x4*)(Ow+(long)row*DMO+ch*8)=v;}
      asm volatile("s_waitcnt lgkmcnt(0)":::"memory"); }
  }
}
__device__ __forceinline__ void swa_phase(char*lds,const bf16*Y,const float*sinks,bf16*O,int vcu,int G,unsigned*queue,const int wv){
  constexpr int NU=BATCH*4*(SEQ/64);
  const int tid=wv*64+lane_id_fresh();
  volatile __attribute__((address_space(3))) int* qs=(volatile __attribute__((address_space(3))) int*)((__attribute__((address_space(3))) char*)lds+SWA_LDS_BYTES);
  int cur=vcu, nxt=vcu+G, tnn=0, tn3=0;
  if(tid==0) tnn=(int)__hip_atomic_fetch_add(queue,1u,__ATOMIC_RELAXED,__HIP_MEMORY_SCOPE_AGENT);
  if(cur<NU){ const int lane=lane_id_fresh(); swa_issue(cur,Y,(unsigned)(uintptr_t)lds,lane,wv); }
  int set=0, par=0;
  while(cur<NU){
    if(tid==0) qs[par]=2*G+tnn;
    swa_unit(cur,(nxt<NU)?nxt:-1,set,Y,sinks,O,lds,wv,queue,tn3);
    cur=nxt; nxt=qs[par]; par^=1; set^=1; tnn=tn3;
  }
  asm volatile("s_waitcnt vmcnt(0) lgkmcnt(0)\n\ts_barrier":::"memory");
}
#undef SBAR
#undef WAIT_BAR
}
namespace mls {
typedef unsigned short bf16_t;
typedef short bf16x8 __attribute__((ext_vector_type(8)));
typedef float f32x4 __attribute__((ext_vector_type(4)));
typedef unsigned u32x4 __attribute__((ext_vector_type(4)));
typedef unsigned u32x2 __attribute__((ext_vector_type(2)));
#define MLAS __attribute__((address_space(3)))
constexpr int SEQ = 8192, NH = 4, DK = 256, DV = 512, L = 64, NC = SEQ / L, YLD = 6144;
constexpr int QF_CH = 4 * 8 * 512, KF_CH = 16 * 2 * 512, VF_CH = 32 * 2 * 512, AF_CH = 4 * 2 * 512;
constexpr int PITCH = 264;
__device__ __forceinline__ float blo(unsigned u) { return __uint_as_float(u << 16); }
__device__ __forceinline__ float bhi(unsigned u) { return __uint_as_float(u & 0xffff0000u); }
__device__ __forceinline__ unsigned pkbf(float lo, float hi) { typedef float f2 __attribute__((ext_vector_type(2))); typedef __bf16 b2 __attribute__((ext_vector_type(2))); f2 v = {lo, hi}; b2 b = __builtin_convertvector(v, b2); return __builtin_bit_cast(unsigned, b); }
__device__ __forceinline__ void glds16(const void* gsrc, unsigned lds_dst) { unsigned keep;
    asm volatile("s_mov_b32 %0, m0\n\ts_mov_b32 m0, %2\n\ts_nop 0\n\tglobal_load_lds_dwordx4 %1, off\n\ts_mov_b32 m0, %0" : "=&s"(keep) : "v"(gsrc), "s"(lds_dst) : "memory"); }

__device__ __forceinline__ void glds16s(const void* sbase, unsigned voff, unsigned lds_dst) { unsigned keep;
    asm volatile("s_mov_b32 %0, m0\n\ts_mov_b32 m0, %3\n\ts_nop 0\n\tglobal_load_lds_dwordx4 %1, %2\n\ts_mov_b32 m0, %0" : "=&s"(keep) : "v"(voff), "s"(sbase), "s"(lds_dst) : "memory"); }

template <class T> __device__ __forceinline__ __attribute__((address_space(1))) T* uniform_ptr(T* p) { const unsigned long long a = (unsigned long long)(uintptr_t)p; unsigned lo = (unsigned)__builtin_amdgcn_readfirstlane((int)(unsigned)a), hi = (unsigned)__builtin_amdgcn_readfirstlane((int)(unsigned)(a >> 32));
    asm volatile("s_nop 4" : "+s"(lo), "+s"(hi));
    return (__attribute__((address_space(1))) T*)(((unsigned long long)hi << 32) | lo); }

typedef short v4i16_t __attribute__((ext_vector_type(4)));
__device__ __forceinline__ u32x4 tr_frag(const MLAS bf16_t* T, int s0, int c0, int lane) {
    const int j = lane & 15, q = j >> 2, p = j & 3;
    const MLAS bf16_t* a0 = T + (s0 + q) * PITCH + c0 + 4 * p;
    const v4i16_t lo = __builtin_amdgcn_ds_read_tr16_b64_v4i16((MLAS v4i16_t*)a0), hi = __builtin_amdgcn_ds_read_tr16_b64_v4i16((MLAS v4i16_t*)(a0 + 4 * PITCH));
    typedef short s8 __attribute__((ext_vector_type(8))); const s8 r = {lo[0], lo[1], lo[2], lo[3], hi[0], hi[1], hi[2], hi[3]};
    return __builtin_bit_cast(u32x4, r);
}
__device__ __forceinline__ void m1_phase(MLAS unsigned char* lds, const bf16_t* Y, const float* GI, const float* LF, bf16_t* QF, bf16_t* KF, bf16_t* VF, bf16_t* AF, float* EG, int vcu, int G, const int wvi) {
    int tid_ = wvi * 64 + lane_id_fresh(); const int tid = tid_, lane = tid & 63, r = lane & 15, g = lane >> 4; const int wid = __builtin_amdgcn_readfirstlane(tid >> 6);
    MLAS bf16_t* B0 = (MLAS bf16_t*)lds; MLAS bf16_t* B1 = B0 + 64 * PITCH; MLAS bf16_t* B2 = B1 + 64 * PITCH; MLAS bf16_t* AM = B2 + 64 * PITCH;
    MLAS float* bv = (MLAS float*)(AM + 64 * 72); MLAS float* wl = bv + 64; MLAS float* wv = wl + 64; MLAS float* eb = wv + 64;
    for (int ch = vcu; ch < 2 * NH * NC; ch += G) {
        const int c = ch % NC, h = (ch / NC) % NH, b = ch / (NC * NH);
        const size_t row0 = (size_t)b * SEQ + (size_t)c * L;
        __syncthreads();
        for (int i = tid; i < 64 * 32; i += 512) { const int rr = i >> 5, cc = i & 31; const bf16_t* src = Y + (row0 + rr) * YLD + h * DK + cc * 8;
            *(MLAS u32x4*)(B0 + rr * PITCH + cc * 8) = *(const u32x4*)src; *(MLAS u32x4*)(B1 + rr * PITCH + cc * 8) = *(const u32x4*)(src + 1024);
            *(MLAS u32x4*)(B2 + rr * PITCH + cc * 8) = *(const u32x4*)(Y + (row0 + rr) * YLD + 2048 + h * DV + cc * 8); }
        if (wid == 0) { const float lf = LF[(row0 + lane) * 4 + h], gi = GI[(row0 + lane) * 4 + h];
            float inc = lf;
#pragma unroll
            for (int o = 1; o < 64; o <<= 1) { const float y = __int_as_float(__builtin_amdgcn_ds_bpermute((lane - o) << 2, __float_as_int(inc))); if (lane >= o) inc += y; }
            const float gt = __int_as_float(__builtin_amdgcn_ds_bpermute(63 << 2, __float_as_int(inc)));
            bv[lane] = inc; wl[lane] = gi - inc; wv[lane] = __expf(gt + gi - inc); eb[lane] = __expf(inc);
            if (lane == 0) EG[ch] = __expf(gt); }
        __syncthreads();
        { const int tt = wid >> 1;
#pragma unroll
          for (int jj = 0; jj < 2; ++jj) { const int st = 2 * (wid & 1) + jj; f32x4 acc = {0.f, 0.f, 0.f, 0.f};
            if (st <= tt) { bf16x8 X[8], Yf[8];
#pragma unroll
                for (int ks = 0; ks < 8; ++ks) { X[ks] = *(const MLAS bf16x8*)(B0 + (16 * tt + r) * PITCH + 32 * ks + 8 * g); Yf[ks] = *(const MLAS bf16x8*)(B1 + (16 * st + r) * PITCH + 32 * ks + 8 * g); }
                __builtin_amdgcn_sched_barrier(0);
#pragma unroll
                for (int ks = 0; ks < 8; ++ks) acc = __builtin_amdgcn_mfma_f32_16x16x32_bf16(X[ks], Yf[ks], acc, 0, 0, 0); }
            const int s = 16 * st + r; const float wls = wl[s];
#pragma unroll
            for (int i = 0; i < 4; ++i) { const int t = 16 * tt + 4 * g + i; const float val = (s <= t) ? __expf(bv[t] + wls) * acc[i] : 0.f; AM[t * 72 + s] = (bf16_t)(pkbf(val, 0.f) & 0xffffu); } } }
#pragma unroll
        for (int f4 = 0; f4 < 4; ++f4) { const int f = wid * 4 + f4, tt = f >> 3, ks = f & 7, t = 16 * tt + r; const float e = eb[t];
            const u32x2 lo = *(const MLAS u32x2*)(B0 + t * PITCH + 32 * ks + 4 * g), hi = *(const MLAS u32x2*)(B0 + t * PITCH + 32 * ks + 16 + 4 * g);
            u32x4 o; o.x = pkbf(blo(lo.x) * e, bhi(lo.x) * e); o.y = pkbf(blo(lo.y) * e, bhi(lo.y) * e); o.z = pkbf(blo(hi.x) * e, bhi(hi.x) * e); o.w = pkbf(blo(hi.y) * e, bhi(hi.y) * e);
            *(u32x4*)(QF + (size_t)ch * QF_CH + (size_t)f * 512 + lane * 8) = o; }
        __syncthreads();
        for (int i = tid; i < 64 * 32; i += 512) { const int rr = i >> 5, cc = i & 31; const float w = wv[rr]; const u32x4 kx = *(const MLAS u32x4*)(B1 + rr * PITCH + cc * 8);
            u32x4 o; o.x = pkbf(blo(kx.x) * w, bhi(kx.x) * w); o.y = pkbf(blo(kx.y) * w, bhi(kx.y) * w); o.z = pkbf(blo(kx.z) * w, bhi(kx.z) * w); o.w = pkbf(blo(kx.w) * w, bhi(kx.w) * w);
            *(MLAS u32x4*)(B1 + rr * PITCH + cc * 8) = o;
            *(MLAS u32x4*)(B0 + rr * PITCH + cc * 8) = *(const u32x4*)(Y + (row0 + rr) * YLD + 2048 + h * DV + 256 + cc * 8); }
        { const int tt = wid >> 1, ks = wid & 1; *(u32x4*)(AF + (size_t)ch * AF_CH + (size_t)wid * 512 + lane * 8) = *(const MLAS u32x4*)(AM + (16 * tt + r) * 72 + 32 * ks + 8 * g); }
        __syncthreads();
#pragma unroll
        for (int f4 = 0; f4 < 4; ++f4) { const int f = wid * 4 + f4, dt = f >> 1, ks = f & 1;
            *(u32x4*)(KF + (size_t)ch * KF_CH + (size_t)f * 512 + lane * 8) = tr_frag(B1, 32 * ks + 8 * g, 16 * dt, lane); }
#pragma unroll
        for (int f8 = 0; f8 < 8; ++f8) { const int f = wid * 8 + f8, et = f >> 1, ks = f & 1; const MLAS bf16_t* Bv = (et >= 16) ? B0 : B2;
            *(u32x4*)(VF + (size_t)ch * VF_CH + (size_t)f * 512 + lane * 8) = tr_frag(Bv, 32 * ks + 8 * g, (16 * et) & 255, lane); }
    }
}

constexpr int BUF_BYTES = (QF_CH + KF_CH + AF_CH) * 2;
constexpr int M2_DEN_OFF = 2 * BUF_BYTES, M2_LDS_BYTES = M2_DEN_OFF + 1024;
constexpr int NSEG = 4, SEGC = NC / NSEG;
template <int PASS>
__device__ __forceinline__ void m2_phase(MLAS unsigned char* lds, char* lds_generic, const bf16_t* Y, const bf16_t* QF, const bf16_t* KF, const bf16_t* VF, const bf16_t* AF, const float* EG, float* CST, float* DSEG, bf16_t* AO, int bx, int G, const int wvi) {
    int tid_ = wvi * 64 + lane_id_fresh(); const int tid = tid_, lane = tid & 63, r = lane & 15, g = lane >> 4; const int wid = __builtin_amdgcn_readfirstlane(tid >> 6);
    const unsigned lds0 = (unsigned)(uintptr_t)lds_generic;
    MLAS float* DEN = (MLAS float*)(lds + M2_DEN_OFF);
    for (int u_ = bx; u_ < 64 * NSEG; u_ += G) { const int u = __builtin_amdgcn_readfirstlane(u_);
        const int bh = u & 7, sl = (u >> 3) & 7, seg = u >> 6, b = bh >> 2, h = bh & 3;
        if (PASS == 0 && seg == NSEG - 1) continue;
        const size_t ch0 = (size_t)bh * NC; const size_t rowb = (size_t)b * SEQ;
        const int et = 4 * sl + wid;
        const int ecol = h * DV + 16 * et + r;
        const int c0 = seg * SEGC;
        f32x4 C[16];
#pragma unroll
        for (int i = 0; i < 16; ++i) C[i] = (f32x4){0.f, 0.f, 0.f, 0.f};
        if (PASS == 1 && seg > 0 && wid < 5) {
            unsigned l_ = (unsigned)lane; asm volatile("" : "+v"(l_));
            const f32x4* c0p = (const f32x4*)CST + ((((size_t)(bh * (NSEG - 1) + 0) * 8 + sl) * 5 + wid) * 16) * 64 + l_;
            const size_t sstr = (size_t)8 * 5 * 16 * 64;
#pragma unroll
            for (int i = 0; i < 16; ++i) C[i] = c0p[(size_t)i * 64];
            if (seg > 1) { const float d1 = DSEG[bh * NSEG + 1];
#pragma unroll
                for (int i = 0; i < 16; ++i) C[i] = C[i] * d1 + c0p[sstr + (size_t)i * 64]; }
            if (seg > 2) { const float d2 = DSEG[bh * NSEG + 2];
#pragma unroll
                for (int i = 0; i < 16; ++i) C[i] = C[i] * d2 + c0p[2 * sstr + (size_t)i * 64]; }
        }
#define M2_DMA(cc, buf) do { const unsigned base_ = lds0 + (buf) * BUF_BYTES; const size_t chx_ = ch0 + (cc); \
            if (PASS == 1) { _Pragma("unroll") for (int p_ = 0; p_ < 9; ++p_) { const int pc_ = wid * 9 + p_; const bf16_t* src_ = (pc_ < 32) ? QF + chx_ * QF_CH + (size_t)pc_ * 512 : (pc_ < 64) ? KF + chx_ * KF_CH + (size_t)(pc_ - 32) * 512 : AF + chx_ * AF_CH + (size_t)(pc_ - 64) * 512; \
                glds16(src_ + lane * 8, (unsigned)__builtin_amdgcn_readfirstlane(base_ + pc_ * 1024)); } } \
            else { _Pragma("unroll") for (int p_ = 0; p_ < 4; ++p_) { const int pc_ = 32 + wid * 4 + p_; glds16(KF + chx_ * KF_CH + (size_t)(pc_ - 32) * 512 + lane * 8, (unsigned)__builtin_amdgcn_readfirstlane(base_ + pc_ * 1024)); } } } while (0)
        __syncthreads();
        M2_DMA(c0, 0);
        bf16x8 vf[2], vfn[2];
        unsigned o1_ = 0x3F803F80u; asm volatile("" : "+v"(o1_));
        const bf16x8 ones = __builtin_bit_cast(bf16x8, (u32x4){o1_, o1_, o1_, o1_});
        if (wid < 4) { vf[0] = *(const bf16x8*)(VF + (ch0 + c0) * VF_CH + (size_t)(et * 2 + 0) * 512 + lane * 8); vf[1] = *(const bf16x8*)(VF + (ch0 + c0) * VF_CH + (size_t)(et * 2 + 1) * 512 + lane * 8); }
        else { vf[0] = ones; vf[1] = ones; }
        vfn[0] = vf[0]; vfn[1] = vf[1];
        float dprod = 1.f;
        unsigned ogoff = (unsigned)((4 * g * YLD + r) * 2), aooff = (unsigned)(4 * g * 2048 + r);
        asm volatile("" : "+v"(ogoff), "+v"(aooff));
        MLAS float* egl = DEN + 128;
        { unsigned t_ = (unsigned)tid; asm volatile("" : "+v"(t_)); if (t_ < (unsigned)SEGC) egl[t_] = EG[ch0 + c0 + t_]; }
        asm volatile("s_waitcnt vmcnt(0) lgkmcnt(0)\n\ts_barrier" ::: "memory");
        for (int ci = 0; ci < SEGC; ++ci) {
            const int c = c0 + ci, buf = ci & 1;
            if (ci + 1 < SEGC) { M2_DMA(c + 1, buf ^ 1);
                if (wid < 4) { const bf16_t* v0_ = VF + (ch0 + c + 1) * VF_CH + (size_t)(et * 2 + 0) * 512 + lane * 8;
                    asm volatile("global_load_dwordx4 %0, %2, off\n\tglobal_load_dwordx4 %1, %2, off offset:1024" : "=&v"(vfn[0]), "=&v"(vfn[1]) : "v"(v0_) : "memory"); } }
            const size_t row0 = rowb + (size_t)c * L;
            __attribute__((address_space(1))) bf16_t* aob = uniform_ptr(AO + row0 * 2048 + h * DV + 16 * et);
            const __attribute__((address_space(1))) bf16_t* ogb = uniform_ptr(Y + row0 * YLD + 4096 + h * DV + 16 * et);
            f32x4 num[4];
            unsigned og[16];
            if (wid < 5) {
                const MLAS unsigned char* qb = lds + buf * BUF_BYTES; const MLAS unsigned char* kb = qb + QF_CH * 2; const MLAS unsigned char* ab = kb + KF_CH * 2;
                const float eg = egl[ci];
                if (PASS == 1) {
                    if (wid < 4) {
#pragma unroll
                        for (int tt = 0; tt < 4; ++tt)
#pragma unroll
                            for (int i = 0; i < 4; ++i) { const __attribute__((address_space(1))) bf16_t* sb_ = ogb + (16 * tt + i) * YLD; asm volatile("global_load_ushort %0, %1, %2" : "=v"(og[tt * 4 + i]) : "v"(ogoff), "s"(sb_) : "memory"); }
                    }
                    bf16x8 yc[8];
#pragma unroll
                    for (int ks = 0; ks < 8; ++ks) { u32x4 w; w.x = pkbf(C[2 * ks][0], C[2 * ks][1]); w.y = pkbf(C[2 * ks][2], C[2 * ks][3]); w.z = pkbf(C[2 * ks + 1][0], C[2 * ks + 1][1]); w.w = pkbf(C[2 * ks + 1][2], C[2 * ks + 1][3]); yc[ks] = __builtin_bit_cast(bf16x8, w); }
                    bf16x8 fA[10], fB[10];
#define M2_LD10(dst, tt_) do { _Pragma("unroll") for (int ks = 0; ks < 8; ++ks) dst[ks] = *(const MLAS bf16x8*)(qb + ((tt_) * 8 + ks) * 1024 + lane * 16); \
                        dst[8] = *(const MLAS bf16x8*)(ab + ((tt_) * 2 + 0) * 1024 + lane * 16); dst[9] = *(const MLAS bf16x8*)(ab + ((tt_) * 2 + 1) * 1024 + lane * 16); } while (0)
#define M2_MM10(src, tt_) do { f32x4 a = {0.f, 0.f, 0.f, 0.f}; _Pragma("unroll") for (int ks = 0; ks < 8; ++ks) a = __builtin_amdgcn_mfma_f32_16x16x32_bf16(src[ks], yc[ks], a, 0, 0, 0); \
                        a = __builtin_amdgcn_mfma_f32_16x16x32_bf16(src[8], vf[0], a, 0, 0, 0); a = __builtin_amdgcn_mfma_f32_16x16x32_bf16(src[9], vf[1], a, 0, 0, 0); num[tt_] = a; } while (0)
                    M2_LD10(fA, 0); __builtin_amdgcn_sched_barrier(0);
                    M2_LD10(fB, 1); __builtin_amdgcn_sched_barrier(0); M2_MM10(fA, 0); __builtin_amdgcn_sched_barrier(0);
                    M2_LD10(fA, 2); __builtin_amdgcn_sched_barrier(0); M2_MM10(fB, 1); __builtin_amdgcn_sched_barrier(0);
                    M2_LD10(fB, 3); __builtin_amdgcn_sched_barrier(0); M2_MM10(fA, 2); __builtin_amdgcn_sched_barrier(0);
                    M2_MM10(fB, 3); __builtin_amdgcn_sched_barrier(0);
#undef M2_LD10
#undef M2_MM10
                    if (wid == 4 && r == 0) {
#pragma unroll
                        for (int tt = 0; tt < 4; ++tt)
#pragma unroll
                            for (int i = 0; i < 4; ++i) DEN[buf * 64 + 16 * tt + 4 * g + i] = num[tt][i];
                    }
                } else dprod *= eg;
                {
                    bf16x8 kA[8], kB[8];
#define M2_LDK(dst, q_) do { _Pragma("unroll") for (int i_ = 0; i_ < 8; ++i_) dst[i_] = *(const MLAS bf16x8*)(kb + ((q_) * 8 + i_) * 1024 + lane * 16); } while (0)
#define M2_MMK(src, q_) do { _Pragma("unroll") for (int d_ = 0; d_ < 4; ++d_) { f32x4 a = C[(q_) * 4 + d_] * eg; a = __builtin_amdgcn_mfma_f32_16x16x32_bf16(src[2 * d_], vf[0], a, 0, 0, 0); a = __builtin_amdgcn_mfma_f32_16x16x32_bf16(src[2 * d_ + 1], vf[1], a, 0, 0, 0); C[(q_) * 4 + d_] = a; } } while (0)
                    M2_LDK(kA, 0); __builtin_amdgcn_sched_barrier(0);
                    M2_LDK(kB, 1); __builtin_amdgcn_sched_barrier(0); M2_MMK(kA, 0); __builtin_amdgcn_sched_barrier(0);
                    M2_LDK(kA, 2); __builtin_amdgcn_sched_barrier(0); M2_MMK(kB, 1); __builtin_amdgcn_sched_barrier(0);
                    M2_LDK(kB, 3); __builtin_amdgcn_sched_barrier(0); M2_MMK(kA, 2); __builtin_amdgcn_sched_barrier(0);
                    M2_MMK(kB, 3); __builtin_amdgcn_sched_barrier(0);
#undef M2_LDK
#undef M2_MMK
                }
            }
            if (PASS == 1 && wid < 4) asm volatile("" : "+v"(og[0]), "+v"(og[1]), "+v"(og[2]), "+v"(og[3]), "+v"(og[4]), "+v"(og[5]), "+v"(og[6]), "+v"(og[7]), "+v"(og[8]), "+v"(og[9]), "+v"(og[10]), "+v"(og[11]), "+v"(og[12]), "+v"(og[13]), "+v"(og[14]), "+v"(og[15]));
            asm volatile("s_waitcnt vmcnt(0) lgkmcnt(0)\n\ts_barrier" : "+v"(vfn[0]), "+v"(vfn[1]) :: "memory");
            __builtin_amdgcn_sched_barrier(0);
            if (PASS == 1 && wid < 4) {
                asm volatile("" : "+v"(aooff));
#pragma unroll
                for (int tt = 0; tt < 4; ++tt) { const f32x4 dn = *(const MLAS f32x4*)(DEN + buf * 64 + 16 * tt + 4 * g);
#pragma unroll
                    for (int i = 0; i < 4; ++i) { const float ov = __uint_as_float((unsigned)og[tt * 4 + i] << 16); const float hv = num[tt][i] * __builtin_amdgcn_rcpf(fmaxf(fabsf(dn[i]), 1.f) * (1.f + __expf(-ov)));
                        aob[aooff + (unsigned)((16 * tt + i) * 2048)] = (bf16_t)(pkbf(hv, 0.f) & 0xffffu); } }
            }
            vf[0] = vfn[0]; vf[1] = vfn[1];
        }
        if (PASS == 0 && wid < 5) {
            f32x4* cp = (f32x4*)CST + ((((size_t)(bh * (NSEG - 1) + seg) * 8 + sl) * 5 + wid) * 16) * 64 + lane;
#pragma unroll
            for (int i = 0; i < 16; ++i) cp[(size_t)i * 64] = C[i];
            if (wid == 0 && lane == 0 && sl == 0) DSEG[bh * NSEG + seg] = dprod;
        }
#undef M2_DMA
    }
}
#undef MLAS
}
struct Frame {
    LAS unsigned char* lds; volatile LAS unsigned* MISC;
    int tid, lane, wave, vcu, G, bx;
};
__device__ __forceinline__ float shx(float v, int mask, int lane) { return __int_as_float(__builtin_amdgcn_ds_bpermute((lane ^ mask) << 2, __float_as_int(v))); }
__device__ __forceinline__ float wave_sum(float v, int lane) {
#pragma unroll
    for (int o = 1; o < 64; o <<= 1) v += shx(v, o, lane);
    return v;
}
__device__ __forceinline__ float bf_lo(unsigned u) { return __uint_as_float(u << 16); }
__device__ __forceinline__ float bf_hi(unsigned u) { return __uint_as_float(u & 0xffff0000u); }
__device__ __forceinline__ float dot8(v4u a, v4u b) {
    float s = bf_lo(a.x) * bf_lo(b.x); s += bf_hi(a.x) * bf_hi(b.x); s += bf_lo(a.y) * bf_lo(b.y); s += bf_hi(a.y) * bf_hi(b.y);
    s += bf_lo(a.z) * bf_lo(b.z); s += bf_hi(a.z) * bf_hi(b.z); s += bf_lo(a.w) * bf_lo(b.w); s += bf_hi(a.w) * bf_hi(b.w); return s;
}
template <int MAP> __device__ __forceinline__ int map_col(int n) {
    if (MAP == 1) { if (n < 2304) { const int hb = n & ~63, d = n & 63; const int p = (d < 32) ? ((d >> 2) * 8 + (d & 3)) : (((d - 32) >> 2) * 8 + 4 + (d & 3)); return hb + p; } return n; }
    if (MAP == 2) { const int hv = (n >= DFF) ? 1 : 0, q = n - hv * DFF; return 256 * (q >> 7) + 128 * hv + (q & 127); }
    return n;
}
template <int MAP, bool FOLD> __device__ __forceinline__ void p0_transpose_item(const float* W, int K, int Nsrc, int Npad, bf16* WT, LAS float* scr, int item, int lane,
                                                                               const float* ng, const float* modp  , unsigned long long* biasp) {
    const int nblk = Npad / 64, kb = item / nblk, nb = item % nblk, k0 = 64 * kb, n0 = 64 * nb;
    { const int n4 = lane & 15, kr = lane >> 4; const int nn = n0 + 4 * n4; const bool ok = nn < Nsrc;
#pragma unroll
      for (int h = 0; h < 2; ++h) { f32x4 v[8];
#pragma unroll
        for (int i = 0; i < 8; ++i) { const int kk = 4 * (8 * h + i) + kr; v[i] = ok ? *(const GAS f32x4*)(W + (size_t)(k0 + kk) * Nsrc + nn) : (f32x4){0.f, 0.f, 0.f, 0.f}; }
#pragma unroll
        for (int i = 0; i < 8; ++i) { const int kk = 4 * (8 * h + i) + kr; LAS float* d = scr + kk * 65 + 4 * n4; d[0] = v[i][0]; d[1] = v[i][1]; d[2] = v[i][2]; d[3] = v[i][3]; } } }
    LDS_WAIT(); asm volatile("" ::: "memory");
    const int c = lane & 7, nr = lane >> 3;
    float gk[2][8], sh[2][8];
    if (FOLD) {
#pragma unroll
        for (int bb = 0; bb < 2; ++bb)
#pragma unroll
            for (int i = 0; i < 8; ++i) { const int k = k0 + 8 * c + i; gk[bb][i] = ng[k] * (1.f + modp[bb * MODN + DM + k]); sh[bb][i] = modp[bb * MODN + k]; }
    }
#pragma unroll
    for (int j = 0; j < 8; ++j) { const int n = nr + 8 * j; const LAS float* s = scr + (8 * c) * 65 + n; float x[8];
#pragma unroll
        for (int i = 0; i < 8; ++i) x[i] = s[i * 65];
        const size_t drow = (size_t)map_col<MAP>(n0 + n);
        if (!FOLD) { v4u o; o.x = pk2(x[0], x[1]); o.y = pk2(x[2], x[3]); o.z = pk2(x[4], x[5]); o.w = pk2(x[6], x[7]); *(GAS v4u*)(WT + drow * K + k0 + 8 * c) = o; }
        else {
#pragma unroll
            for (int bb = 0; bb < 2; ++bb) { v4u o; o.x = pk2(x[0] * gk[bb][0], x[1] * gk[bb][1]); o.y = pk2(x[2] * gk[bb][2], x[3] * gk[bb][3]); o.z = pk2(x[4] * gk[bb][4], x[5] * gk[bb][5]); o.w = pk2(x[6] * gk[bb][6], x[7] * gk[bb][7]);
                *(GAS v4u*)(WT + (size_t)bb * Npad * K + drow * K + k0 + 8 * c) = o;
                float p = 0.f;
#pragma unroll
                for (int i = 0; i < 8; ++i) p += x[i] * sh[bb][i];
                p += shx(p, 1, lane); p += shx(p, 2, lane); p += shx(p, 4, lane);
                if (c == 0 && biasp) atomicAdd(biasp + (size_t)bb * Npad + drow, (unsigned long long)(long long)(p * BIAS_SCALE)); } }
    }
    LDS_WAIT(); asm volatile("" ::: "memory");
}
constexpr int BG_I_O = (DM / 64) * (DM / 64), BG_I_D = (DFF / 64) * (DM / 64), BG_I_U = (DM / 64) * (NUP / 64), BG_I_A = (DM / 64) * (A_IN / 64), BG_I_BC = (DM / 64) * (BC_PAD / 64);
struct Ptrs {
    const float *x, *c; const int* pos; const float *mod_w, *mod_b, *norm_g, *final_g, *a_w_in, *a_sinks, *a_w_out, *b_w_in, *b_f_bias, *b_w_out, *c_w_in, *c_gate_bias, *c_w_out, *w_up, *conv_w, *conv_b, *w_dn;
    float* out; unsigned char* ws;
};
__device__ __forceinline__ void p0a_prologue(Frame& F, const Ptrs& P) {
    unsigned char* ws = P.ws;
    const int gw = F.vcu * NWAVES + F.wave, NGW = F.G * NWAVES;
    {
        LAS float* ca = (LAS float*)(F.lds);
        LAS float* red = ca + 2 * DM;
        for (int i = F.tid; i < 2 * DM; i += 512) { const float v = P.c[i]; ca[i] = v / (1.f + __expf(-v)); }
        __syncthreads();
        const int ks = F.tid / 48, cg = F.tid % 48;
        for (int u = F.vcu; u < NL * (MODN / 192); u += F.G) {
            const int l = u / (MODN / 192), n0 = (u % (MODN / 192)) * 192 + 4 * cg;
            f32x4 a0 = {0.f, 0.f, 0.f, 0.f}, a1 = a0;
            if (ks < 8) { const float* wp = P.mod_w + ((size_t)l * DM + ks * 256) * MODN + n0;
#pragma unroll 8
                for (int k = 0; k < 256; ++k) { const f32x4 w = *(const GAS f32x4*)(wp + (size_t)k * MODN); a0 += w * ca[ks * 256 + k]; a1 += w * ca[DM + ks * 256 + k]; } }
            __syncthreads();
            if (ks < 8) { *(LAS f32x4*)(red + (ks * 48 + cg) * 8) = a0; *(LAS f32x4*)(red + (ks * 48 + cg) * 8 + 4) = a1; }
            __syncthreads();
            if (F.tid < 96) { const int b = F.tid / 48; f32x4 s = *(const GAS f32x4*)(P.mod_b + (size_t)l * MODN + n0);
#pragma unroll
                for (int q = 0; q < 8; ++q) s += *(LAS f32x4*)(red + (q * 48 + cg) * 8 + 4 * b);
                *(GAS f32x4*)((float*)(ws + WS_MODV) + (size_t)(l * 2 + b) * MODN + n0) = s; }
        }
        __syncthreads();
    }
    {
        float* RC = (float*)(ws + WS_RC); float* RS = (float*)(ws + WS_RS);
        for (int i = F.vcu * 512 + F.tid; i < M * 32; i += F.G * 512) { const int m = i >> 5, f = i & 31;
            const float inv = powf(10000.f, -(float)(2 * f) / 64.f); const float ang = (float)P.pos[m] * inv; float sv, cv; sincosf(ang, &sv, &cv); RC[i] = cv; RS[i] = sv; }
    }
    __syncthreads();
}
__host__ __device__ constexpr int bg_lim(int l) { return (l + 1) * (BG_I_O + BG_I_U + BG_I_D) + (l >= 0 ? BG_I_BC : 0) + (l >= 1 ? BG_I_BC : 0) + (l >= 2 ? BG_I_A : 0); }
constexpr int NBG = bg_lim(3);
typedef const __attribute__((address_space(4))) Args* bg_args_t;
__device__ __forceinline__ void bg_item(const Ptrs& P, bg_args_t ap, LAS float* scr, int t, int lane) {
    unsigned char* ws = P.ws; const float* MODV = (const float*)(ws + WS_MODV); unsigned long long* BIAS = (unsigned long long*)(ws + WS_BIAS);
    const int l = (t >= bg_lim(2)) ? 3 : (t >= bg_lim(1)) ? 2 : (t >= bg_lim(0)) ? 1 : 0;
    int r = t - ((l == 3) ? bg_lim(2) : (l == 2) ? bg_lim(1) : (l == 1) ? bg_lim(0) : 0);
    if (r < BG_I_O + BG_I_U + BG_I_D) {
        if (r >= BG_I_O && r < BG_I_O + BG_I_U) { r -= BG_I_O;
            p0_transpose_item<2, true>(P.w_up + (size_t)l * DM * NUP, DM, NUP, NUP, (bf16*)(ws + WS_WUP) + (size_t)l * 2 * NUP * DM, scr, r, lane, P.norm_g + (size_t)(l * 2 + 1) * DM, MODV + (size_t)l * 2 * MODN + 3 * DM, BIAS + BIAS_UP + (size_t)l * 2 * NUP); }
        else { const bool dn = r >= BG_I_O; if (dn) r -= BG_I_O + BG_I_U; const int kind = l % 3, j = l / 3;
            const float* src = dn ? P.w_dn + (size_t)l * DFF * DM : (const float*)ap->in[9 + 3 * kind] + (size_t)j * DM * DM;
            p0_transpose_item<0, false>(src, dn ? DFF : DM, DM, DM, dn ? (bf16*)(ws + WS_WDN) + (size_t)l * DM * DFF : (bf16*)(ws + WS_WOUT) + (size_t)l * DM * DM, scr, r, lane, nullptr, nullptr, nullptr); }
    } else { r -= BG_I_O + BG_I_U + BG_I_D; const int ln = l + 1;
        if (ln == 3) p0_transpose_item<1, true>(P.a_w_in + (size_t)DM * A_IN, DM, A_IN, A_IN, (bf16*)(ws + WS_WAIN) + (size_t)2 * A_IN * DM, scr, r, lane, P.norm_g + (size_t)(3 * 2) * DM, MODV + (size_t)3 * 2 * MODN, BIAS + BIAS_A + (size_t)2 * A_IN);
        else p0_transpose_item<0, true>((const float*)ap->in[10 + 3 * (ln - 1)]  , DM, ln == 1 ? B_IN : C_IN, BC_PAD, (bf16*)(ws + (ln == 1 ? WS_WBIN : WS_WCIN)), scr, r, lane, P.norm_g + (size_t)(ln * 2) * DM, MODV + (size_t)ln * 2 * MODN, BIAS + (ln == 1 ? BIAS_B : BIAS_C)); }
}
#ifndef BG_PER_WAVE0
#define BG_PER_WAVE0 16
#endif
constexpr int BG_N0 = 128 * 7 * BG_PER_WAVE0, BG_N3 = bg_lim(3) - bg_lim(2);
static_assert(BG_N0 <= bg_lim(2) && BG_N3 <= bg_lim(3) - bg_lim(2), "deferred items are taken from the layer's own group: out / up / down (+ next in-projection), all consumed at least one seam after the in-projection's");
struct BgList { int base, n, j, stride; };
__device__ __forceinline__ BgList bg_list(int l, int bx, int G, int wave) {
    BgList L; const int first_idle = 640 % G; const bool on = (l == 0 || l == 3) && bx >= first_idle && wave >= 1;
    L.base = (l == 0) ? 0 : bg_lim(3) - BG_N3; L.n = on ? ((l == 0) ? BG_N0 : BG_N3) : 0; L.stride = (G - first_idle) * 7; L.j = on ? (bx - first_idle) * 7 + wave - 1 : 0; return L;
}
__device__ __forceinline__ void bg_finish(const Ptrs& P, bg_args_t ap, const BgList L, volatile LAS unsigned* st, LAS float* scr, int wave, int lane) {
    for (int idx = L.j + L.stride * (int)st[8 + wave]; idx < L.n; idx += L.stride) bg_item(P, ap, scr, L.base + idx, lane);
    __syncthreads();
}
__device__ __forceinline__ void xcd_barrier_bg(const XcdBarrier& b, const Ptrs& P, bg_args_t ap, const BgList L, LAS float* scr, int wave, int lane) {
    asm volatile("s_waitcnt vmcnt(0)" ::: "memory");
    __syncthreads();
    if (wave == 0) {
      if (lane == 0) {
        unsigned* bar = b.bar;
        __builtin_amdgcn_s_waitcnt(0);
        unsigned nloc = b.st[0], nx = b.st[1];
        if (nloc == 0u) { xcd_barrier_complete(bar, b.x, nloc, nx); b.st[0] = nloc; b.st[1] = nx; }
        const unsigned old = xb_add(&bar[XB_XSUB(b.x)], 1u);
        const unsigned gen = old / nloc;
        if (old + 1u == (gen + 1u) * nloc) {
            __builtin_amdgcn_fence(__ATOMIC_RELEASE, "agent");
            asm volatile("s_waitcnt vmcnt(0)" ::: "memory");
            const unsigned og = xb_add(&bar[XB_TOP], 1u);
            const unsigned tg = og / nx;
            if (og + 1u == (tg + 1u) * nx) xb_add(&bar[XB_TOPGEN], 1u);
            else XB_SPIN(xb_ld(&bar[XB_TOPGEN]) == tg, bar);
            __builtin_amdgcn_fence(__ATOMIC_ACQUIRE, "agent");
            xb_add(&bar[XB_XGEN(b.x)], 1u);
            asm volatile("s_waitcnt vmcnt(0)" ::: "memory");
        } else {
            XB_SPIN(xb_ld(&bar[XB_XGEN(b.x)]) == gen, bar);
            __builtin_amdgcn_fence(__ATOMIC_ACQUIRE, "agent");
            asm volatile("s_waitcnt vmcnt(0)" ::: "memory");
        }
        b.st[2] = 1u;
      }
    } else {
        unsigned n = 0u;
        for (;;) {
            if (b.st[2] != 0u) break;
            const int idx = L.j + L.stride * (int)n;
            if (idx >= L.n) { while (b.st[2] == 0u) __builtin_amdgcn_s_sleep(8); break; }
            bg_item(P, ap, scr, L.base + idx, lane); ++n;
        }
        if (lane == 0) b.st[8 + wave] = n;
    }
    __syncthreads();
    if (wave == 0 && lane == 0) b.st[2] = 0u;
}
__device__ __forceinline__ void p0b_prologue(Frame& F, const Ptrs& P, bg_args_t ap, const bool nobias = false  ) {
    unsigned char* ws = P.ws;
    LAS float* scr = (LAS float*)(F.lds + RING_OFF + F.wave * 17408);
    const int gw = F.vcu * NWAVES + F.wave, NGW = F.G * NWAVES;
    const float* MODV = (const float*)(ws + WS_MODV); unsigned long long* BIAS = nobias ? (unsigned long long*)nullptr : (unsigned long long*)(ws + WS_BIAS);
    constexpr int NP = NBG - BG_N0 - BG_N3;
    for (int it = gw; it < NP + BG_I_A; it += NGW) { const int r = NP + BG_I_A - 1 - it;
        if (r < BG_I_A) p0_transpose_item<1, true>(P.a_w_in, DM, A_IN, A_IN, (bf16*)(ws + WS_WAIN), scr, r, F.lane, P.norm_g, MODV, BIAS ? BIAS + BIAS_A : BIAS);
        else bg_item(P, ap, scr, r - BG_I_A + BG_N0, F.lane); }
    {
        bf16* XB = (bf16*)(ws + WS_HN); unsigned long long* SS0 = (unsigned long long*)(ws + WS_SS);
        for (int m = gw; m < M; m += NGW) {
            const GAS f32x4* xr = (const GAS f32x4*)(P.x + (size_t)m * DM) + F.lane; GAS unsigned long long* o8 = (GAS unsigned long long*)(XB + (size_t)m * DM) + F.lane;
            float s = 0.f;
#pragma unroll
            for (int j = 0; j < 8; ++j) { const f32x4 v = xr[64 * j]; s += (v.x * v.x + v.y * v.y) + (v.z * v.z + v.w * v.w); o8[64 * j] = (unsigned long long)pk2(v.x, v.y) | ((unsigned long long)pk2(v.z, v.w) << 32); }
            s = wave_sum(s, F.lane); if (F.lane == 0) SS0[m] = (unsigned long long)(s * SS_SCALE);
        }
    }
    __syncthreads();
}
__device__ __forceinline__ void final_norm_phase(Frame& F, const bf16* xin, const long long* ss, const float* g, float* out) {
    for (int it = F.vcu * 512 + F.tid; it < M * (DM / 8); it += F.G * 512) { const int m = it / (DM / 8), c8 = it % (DM / 8);
        const float rstd = __builtin_amdgcn_rsqf((float)ss[m] * (SS_INV / DM) + 1e-6f);
        const v4u w = *(const GAS v4u*)(xin + (size_t)it * 8); const f32x4 g0 = *(const GAS f32x4*)(g + 8 * c8), g1 = *(const GAS f32x4*)(g + 8 * c8 + 4);
        const f32x4 v0 = {bf_lo(w.x), bf_hi(w.x), bf_lo(w.y), bf_hi(w.y)}, v1 = {bf_lo(w.z), bf_hi(w.z), bf_lo(w.w), bf_hi(w.w)};
        *(GAS f32x4*)(out + (size_t)it * 8) = (v0 * rstd) * g0; *(GAS f32x4*)(out + (size_t)it * 8 + 4) = (v1 * rstd) * g1; }
}
__device__ __forceinline__ void scan_phase(Frame& F, const float* LF, int NH, float* Ft) {
    LAS float* wt = (LAS float*)(F.lds);
    for (int sq = F.bx; sq < BATCH * NH; sq += F.G) {
        const int b = sq / NH, h = sq % NH;
        const float* src = LF + ((size_t)b * SEQ + F.tid * 16) * NH + h;
        float p[16];
#pragma unroll
        for (int i = 0; i < 16; ++i) p[i] = src[(size_t)i * NH];
#pragma unroll
        for (int i = 1; i < 16; ++i) p[i] += p[i - 1];
        const float tot = p[15]; float inc = tot;
#pragma unroll
        for (int o = 1; o < 64; o <<= 1) { const float y = __int_as_float(__builtin_amdgcn_ds_bpermute((F.lane - o) << 2, __float_as_int(inc))); if (F.lane >= o) inc += y; }
        __syncthreads();
        if (F.lane == 63) wt[F.wave] = inc;
        __syncthreads();
        float off = inc - tot;
#pragma unroll
        for (int w = 0; w < 8; ++w) if (w < F.wave) off += wt[w];
        GAS f32x4* dst = (GAS f32x4*)(Ft + (size_t)sq * SEQ + F.tid * 16);
#pragma unroll
        for (int q = 0; q < 4; ++q) dst[q] = (f32x4){off + p[4 * q], off + p[4 * q + 1], off + p[4 * q + 2], off + p[4 * q + 3]};
    }
}
__device__ __forceinline__ void conv_act_phase(Frame& F, const bf16* U, const float* cw, const float* cb, bf16* ACT) {
    constexpr int CPR = DFF / 8;
    for (int it = F.vcu * 512 + F.tid; it < M * CPR; it += F.G * 512) {
        const int row = it / CPR, col = (it % CPR) * 8, t = row & (SEQ - 1);
        float y[2][8];
#pragma unroll
        for (int hv = 0; hv < 2; ++hv) { const int cc = col + hv * DFF; const bf16* up = U + (size_t)row * NUP + cc;
            const v4u u2 = *(const GAS v4u*)up; v4u u1 = {0u, 0u, 0u, 0u}, u0 = u1;
            if (t >= 1) u1 = *(const GAS v4u*)(up - NUP); if (t >= 2) u0 = *(const GAS v4u*)(up - 2 * NUP);
            const unsigned a2[4] = {u2.x, u2.y, u2.z, u2.w}, a1[4] = {u1.x, u1.y, u1.z, u1.w}, a0[4] = {u0.x, u0.y, u0.z, u0.w};
#pragma unroll
            for (int e = 0; e < 8; ++e) { const float x2 = (e & 1) ? bf_hi(a2[e >> 1]) : bf_lo(a2[e >> 1]), x1 = (e & 1) ? bf_hi(a1[e >> 1]) : bf_lo(a1[e >> 1]), x0 = (e & 1) ? bf_hi(a0[e >> 1]) : bf_lo(a0[e >> 1]);
                y[hv][e] = x0 * cw[cc + e] + x1 * cw[NUP + cc + e] + x2 * cw[2 * NUP + cc + e] + cb[cc + e]; } }
        float a[8];
#pragma unroll
        for (int e = 0; e < 8; ++e) a[e] = y[0][e] / (1.f + __expf(-y[0][e])) * y[1][e];
        v4u o; o.x = pk2(a[0], a[1]); o.y = pk2(a[2], a[3]); o.z = pk2(a[4], a[5]); o.w = pk2(a[6], a[7]);
        *(GAS v4u*)(ACT + (size_t)row * DFF + col) = o;
    }
}

__device__ __forceinline__ void fixup_phase(Frame& F, const float* HU, const float* cw, const float* cb, bf16* ACT) {
    for (int it = F.vcu * 512 + F.tid; it < 64 * DFF; it += F.G * 512) {
        const int pm = it / DFF, j = it % DFF; if ((pm & 31) == 0) continue;
        const int pg = 256 * (j >> 7) + (j & 127);
        float act[2];
        float y0[2], y1[2];
#pragma unroll
        for (int hv = 0; hv < 2; ++hv) { const int pc = pg + 128 * hv, lc = j + hv * DFF;
            const float um2 = HU[(size_t)((pm - 1) * 4 + 2) * NUP + pc], um1 = HU[(size_t)((pm - 1) * 4 + 3) * NUP + pc], u0 = HU[(size_t)(pm * 4 + 0) * NUP + pc], u1 = HU[(size_t)(pm * 4 + 1) * NUP + pc];
            const float w0 = cw[lc], w1 = cw[NUP + lc], w2 = cw[2 * NUP + lc], bb = cb[lc];
            y0[hv] = w0 * um2 + w1 * um1 + w2 * u0 + bb; y1[hv] = w0 * um1 + w1 * u0 + w2 * u1 + bb; }
        act[0] = y0[0] * __builtin_amdgcn_rcpf(1.f + __expf(-y0[0])) * y0[1]; act[1] = y1[0] * __builtin_amdgcn_rcpf(1.f + __expf(-y1[0])) * y1[1];
        ACT[(size_t)(pm * 256) * DFF + j] = (bf16)f2bf(act[0]); ACT[(size_t)(pm * 256 + 1) * DFF + j] = (bf16)f2bf(act[1]);
    }
}
template <int KIND> __device__ __forceinline__ void gate_rows(const bf16* XB, const bf16* Wc  , const long long* ss, const long long* bias  , const float* gbias, float* G0, float* G1, int bx, int G, const int wvi) {
    const int lane = lane_id_fresh(), r = lane & 15, g = lane >> 4, rt = wvi >> 1, ct = wvi & 1;
    if (KIND == 2 && ct == 1) return;
    for (int rb = bx; rb < M / 64; rb += G) {
        const int row0 = rb * 64, b = (row0 >= SEQ) ? 1 : 0;
        const bf16* xr = XB + (size_t)(row0 + 16 * rt + r) * DM + 8 * g;
        const bf16* wr = Wc + ((size_t)b * BC_PAD + 6144 + 16 * ct + r) * DM + 8 * g;
        f32x4 acc = {0.f, 0.f, 0.f, 0.f};
        bf16x8 X[3][8], Yf[3][8];
#define GR_LD(s_, k0_) do { _Pragma("unroll") for (int i = 0; i < 8; ++i) { X[s_][i] = *(const GAS bf16x8*)(xr + (k0_) + 32 * i); Yf[s_][i] = *(const GAS bf16x8*)(wr + (k0_) + 32 * i); } } while (0)
        GR_LD(0, 0); GR_LD(1, 256); GR_LD(2, 512);
#pragma unroll
        for (int k = 0; k < DM / 256; ++k) {
#pragma unroll
            for (int i = 0; i < 8; ++i) acc = __builtin_amdgcn_mfma_f32_16x16x32_bf16(X[k % 3][i], Yf[k % 3][i], acc, 0, 0, 0);
            if (k + 3 < DM / 256) GR_LD(k % 3, (k + 3) * 256); }
#undef GR_LD
        const int col = 16 * ct + r; typedef unsigned u2_ __attribute__((ext_vector_type(2)));
        const u2_ bw = *(const GAS u2_*)(bias + (size_t)b * BC_PAD + 6144 + col); const float bs = pg8::fx2f(bw[0], bw[1]) * BIAS_INV;
#pragma unroll
        for (int i = 0; i < 4; ++i) { const int row = row0 + 16 * rt + 4 * g + i; const u2_ sv = *(const GAS u2_*)(ss + row);
            const float v = acc[i] * __builtin_amdgcn_rsqf(pg8::fx2f(sv[0], sv[1]) * (SS_INV / 2048.f) + 1e-6f) + bs;
            if (KIND == 1) G0[(size_t)row * 32 + col] = pg8::log_sigmoid_f(v + gbias[col]);
            else if (col < 4) G0[(size_t)row * 4 + col] = v + gbias[col];
            else if (col < 8) G1[(size_t)row * 4 + col - 4] = pg8::log_sigmoid_f(v + gbias[col]); }
    }
}
template <int MODE, int DK, int DV>
__device__ __forceinline__ void naive_mixer(Frame& F, const bf16* Y, int ldy, int qoff, int koff, int voff, int ooff, int NH, int GQ, const float* Ft, const float* GI, const float* sinks, bf16* AO) {
    constexpr int QP = DK + 8, DVT = DV / 8, NQT = SEQ / 64;
    LAS bf16* Qs = (LAS bf16*)(F.lds);
    LAS bf16* Ks = Qs + 64 * QP;
    LAS bf16* Vs = Ks + 32 * QP;
    LAS float* Ps = (LAS float*)(Vs + 32 * DV);
    const int tid = F.tid, qi = tid >> 3, j8 = tid & 7;
    const float NEGINF = -__builtin_inff();
    for (int u = F.vcu; u < BATCH * NH * NQT; u += F.G) {
        const int qt = (NQT - 1) - (u % NQT), bh = u / NQT, h = bh % NH, b = bh / NH, hk = h / GQ;
        const int q0 = qt * 64; const size_t rowbase = (size_t)b * SEQ;
        __syncthreads();
        for (int c = tid; c < 64 * DK / 8; c += 512) { const int r = c / (DK / 8), cc = c % (DK / 8); *(LAS v4u*)(Qs + r * QP + cc * 8) = *(const GAS v4u*)(Y + (rowbase + q0 + r) * ldy + qoff + h * DK + cc * 8); }
        float o[DVT];
#pragma unroll
        for (int e = 0; e < DVT; ++e) o[e] = 0.f;
        const int t = q0 + qi;
        float m = (MODE == 0) ? sinks[h] * LOG2E : NEGINF, l = (MODE == 0) ? 1.f : 0.f, ft_t = 0.f;
        const float* Fh = Ft + (size_t)(b * NH + h) * SEQ;
        if (MODE >= 1) ft_t = Fh[t];
        const int kt_hi = (q0 + 63) / 32; int kt_lo = 0; if (MODE == 0) kt_lo = (q0 >= 127 ? q0 - 127 : 0) / 32;
        for (int kt = kt_lo; kt <= kt_hi; ++kt) {
            __syncthreads();
            for (int c = tid; c < 32 * DK / 8; c += 512) { const int r = c / (DK / 8), cc = c % (DK / 8); *(LAS v4u*)(Ks + r * QP + cc * 8) = *(const GAS v4u*)(Y + (rowbase + kt * 32 + r) * ldy + koff + hk * DK + cc * 8); }
            for (int c = tid; c < 32 * DV / 8; c += 512) { const int r = c / (DV / 8), cc = c % (DV / 8); *(LAS v4u*)(Vs + r * DV + cc * 8) = *(const GAS v4u*)(Y + (rowbase + kt * 32 + r) * ldy + voff + hk * DV + cc * 8); }
            __syncthreads();
#pragma unroll
            for (int c4 = 0; c4 < 4; ++c4) {
                const int kk = j8 + 8 * c4, s = kt * 32 + kk;
                float dot = 0.f;
#pragma unroll 4
                for (int d = 0; d < DK; d += 8) dot += dot8(*(LAS v4u*)(Qs + qi * QP + d), *(LAS v4u*)(Ks + kk * QP + d));
                float val;
                if (MODE == 0) val = (s <= t && t - s < 128) ? dot : NEGINF;
                else if (MODE == 1) val = (s <= t) ? dot + (ft_t - Fh[s]) * LOG2E : NEGINF;
                else val = (s <= t) ? __expf(ft_t - Fh[s] + GI[(rowbase + s) * 4 + h]) * dot : 0.f;
                Ps[qi * 33 + kk] = val;
            }
            __syncthreads();
            if (MODE < 2) {
                float tm = NEGINF;
#pragma unroll 8
                for (int kk = 0; kk < 32; ++kk) tm = fmaxf(tm, Ps[qi * 33 + kk]);
                const float mnew = fmaxf(m, tm);
                if (mnew > NEGINF) {
                    const float sc = exp2f(m - mnew); l *= sc;
#pragma unroll
                    for (int e = 0; e < DVT; ++e) o[e] *= sc;
#pragma unroll 1
                    for (int kk = 0; kk < 32; ++kk) { const float p = exp2f(Ps[qi * 33 + kk] - mnew); l += p;
#pragma unroll
                        for (int e8 = 0; e8 < DVT; e8 += 8) { const v4u vv = *(LAS v4u*)(Vs + kk * DV + j8 * DVT + e8);
                            o[e8 + 0] += p * bf_lo(vv.x); o[e8 + 1] += p * bf_hi(vv.x); o[e8 + 2] += p * bf_lo(vv.y); o[e8 + 3] += p * bf_hi(vv.y);
                            o[e8 + 4] += p * bf_lo(vv.z); o[e8 + 5] += p * bf_hi(vv.z); o[e8 + 6] += p * bf_lo(vv.w); o[e8 + 7] += p * bf_hi(vv.w); } }
                    m = mnew;
                }
            } else {
#pragma unroll 1
                for (int kk = 0; kk < 32; ++kk) { const float p = Ps[qi * 33 + kk]; l += p;
#pragma unroll
                    for (int e8 = 0; e8 < DVT; e8 += 8) { const v4u vv = *(LAS v4u*)(Vs + kk * DV + j8 * DVT + e8);
                        o[e8 + 0] += p * bf_lo(vv.x); o[e8 + 1] += p * bf_hi(vv.x); o[e8 + 2] += p * bf_lo(vv.y); o[e8 + 3] += p * bf_hi(vv.y);
                        o[e8 + 4] += p * bf_lo(vv.z); o[e8 + 5] += p * bf_hi(vv.z); o[e8 + 6] += p * bf_lo(vv.w); o[e8 + 7] += p * bf_hi(vv.w); } }
            }
        }
        const float inv = (MODE < 2) ? 1.f / l : 1.f / fmaxf(fabsf(l), 1.f);
        bf16* op = AO + (rowbase + t) * DM + h * DV + j8 * DVT;
#pragma unroll
        for (int e8 = 0; e8 < DVT; e8 += 8) {
            float r[8];
#pragma unroll
            for (int e = 0; e < 8; ++e) r[e] = o[e8 + e] * inv;
            if (MODE == 2) { const v4u og = *(const GAS v4u*)(Y + (rowbase + t) * ldy + ooff + h * DV + j8 * DVT + e8); const unsigned ow[4] = {og.x, og.y, og.z, og.w};
#pragma unroll
                for (int e = 0; e < 8; ++e) { const float ov = (e & 1) ? bf_hi(ow[e >> 1]) : bf_lo(ow[e >> 1]); r[e] *= 1.f / (1.f + __expf(-ov)); } }
            v4u w; w.x = pk2(r[0], r[1]); w.y = pk2(r[2], r[3]); w.z = pk2(r[4], r[5]); w.w = pk2(r[6], r[7]);
            *(GAS v4u*)(op + e8) = w;
        }
    }
}
constexpr int PH_L0 = 2, PH_FINAL = PH_L0 + 10 * NL, PH_END = PH_FINAL + 1;
__global__ void __launch_bounds__(NWAVES * 64, 2) fwd_kernel(Args args_unused) {
    extern __shared__ __attribute__((aligned(16))) unsigned char lds[];
    typedef const __attribute__((address_space(4))) Args* cargs_t;
#define ARGS() ({ cargs_t _a = (cargs_t)__builtin_amdgcn_kernarg_segment_ptr(); asm volatile("" : "+s"(_a)); _a; })
#define INF32(i) ((const float*)ap->in[i])
#define MKFRAME() Frame F; { int t_ = wv_ * 64 + lane_id_fresh(); F.lds = (LAS unsigned char*)lds; F.MISC = (volatile LAS unsigned*)(F.lds + MISC_OFF); F.tid = t_; F.lane = t_ & 63; F.wave = __builtin_amdgcn_readfirstlane(t_ >> 6); \
        F.G = gridDim.x; int bx_ = blockIdx.x; asm volatile("" : "+s"(bx_)); F.bx = bx_; F.vcu = (F.G % 8 == 0) ? (bx_ % 8) * (F.G / 8) + bx_ / 8 : bx_; }
    int lo, hi;
    const int wv_ = __builtin_amdgcn_readfirstlane((int)threadIdx.x >> 6);
    { cargs_t ap = ARGS(); lo = ap->ph_lo; hi = ap->ph_hi;
      for (int u = threadIdx.x; u < (LDS_BYTES - LDSCTL_OFF) / 4; u += NWAVES * 64) ((LAS unsigned*)((LAS unsigned char*)lds + LDSCTL_OFF))[u] = 0u;
      __syncthreads();
      if (hi - lo > 1) (void)xcd_barrier_post((unsigned*)(ap->ws + WS_CTL) + CW_BAR, (volatile LAS unsigned*)((LAS unsigned char*)lds + MISC_OFF) + 8); }
#ifndef USE_NAIVE_MLSTM
#define USE_NAIVE_MLSTM 0
#endif
#ifndef USE_NAIVE_SWA
#define USE_NAIVE_SWA 0
#endif
#ifndef USE_NAIVE_FOX
#define USE_NAIVE_FOX 0
#endif
#ifndef PHMASK
#define PHMASK 0xffff
#endif
#define ON(n) (((PHMASK) >> (n)) & 1)
#define IN(k) (lo <= (k) && (k) < hi)
#ifndef PROBE_REP
#define PROBE_REP 0
#endif
#ifndef PROBE_KIND
#define PROBE_KIND 7
#endif
#define REPS(n, kindv) ((((PROBE_REP) >> (n)) & 1) && (((PROBE_KIND) >> (kindv)) & 1) ? 2 : 1)
#define GRIDBAR() do { cargs_t ap_ = ARGS(); XcdBarrier b_; b_.bar = (unsigned*)(ap_->ws + WS_CTL) + CW_BAR; b_.x = xb_xcc_id(); b_.st = (volatile LAS unsigned*)((LAS unsigned char*)lds + MISC_OFF) + 8; xcd_barrier(b_); } while (0)
#define SEAM(k) do { if (IN((k) + 1)) { cargs_t ap_ = ARGS(); XcdBarrier b_; b_.bar = (unsigned*)(ap_->ws + WS_CTL) + CW_BAR; b_.x = xb_xcc_id(); b_.st = (volatile LAS unsigned*)((LAS unsigned char*)lds + MISC_OFF) + 8; xcd_barrier(b_); } } while (0)

#define LOADP() Ptrs P; P.x = INF32(0); P.c = INF32(1); P.pos = (const int*)ap->in[2]; P.mod_w = INF32(3); P.mod_b = INF32(4); \
        P.norm_g = INF32(5); P.final_g = INF32(6); P.a_w_in = INF32(7); P.a_sinks = INF32(8); P.a_w_out = INF32(9); \
        P.b_w_in = INF32(10); P.b_f_bias = INF32(11); P.b_w_out = INF32(12); P.c_w_in = INF32(13); P.c_gate_bias = INF32(14); \
        P.c_w_out = INF32(15); P.w_up = INF32(16); P.conv_w = INF32(17); P.conv_b = INF32(18); P.w_dn = INF32(19); P.out = ap->out; P.ws = ap->ws;
    if (ON(0) && IN(0)) { for (int rep_ = 0; rep_ < REPS(0, 0); ++rep_) { if (rep_) GRIDBAR(); { MKFRAME(); cargs_t ap = ARGS(); LOADP(); p0a_prologue(F, P); } } SEAM(0); }
    if (ON(0) && IN(1)) { MKFRAME(); cargs_t ap = ARGS(); LOADP(); p0b_prologue(F, P, ap); SEAM(1); }

    for (int l = 0; l < NL; ++l) {
        const int kind = l % 3, j = l / 3, pb = PH_L0 + 10 * l;
#define XIN() ((l == 0) ? INF32(0) : (const float*)ap->out)
#define MODP() ((const float*)(ws + WS_MODV) + (size_t)l * 2 * MODN)
#define SSIN(sub) ((const float*)(ws + WS_SS) + (size_t)(l * 2 + (sub)) * M)
#define SSOUT(idx) ((float*)(ws + WS_SS) + (size_t)(idx) * M)
        if (ON(2) && IN(pb + 1)) { for (int rep_ = 0; rep_ < REPS(2, kind); ++rep_) { if (rep_) GRIDBAR(); { MKFRAME(); cargs_t ap = ARGS(); unsigned char* ws = ap->ws; const bf16* HN = (const bf16*)(ws + WS_HN); bf16* Y = (bf16*)(ws + WS_Y);
            if (kind == 0) { pg8::Gemm g{HN, (const bf16*)(ws + WS_WAIN) + (size_t)j * 2 * A_IN * DM, M, A_IN, DM, (size_t)A_IN * DM}; pg8::StaticOrder S; S.init(M, A_IN, F.G, F.bx);
                pg8::EpiIn<0> E{l, 0};
                pg8::gemm_phase<pg8::EpiIn<0>, pg8::StaticOrder, true, true>(F.lds + RING_OFF, g, S, E, wv_); }
            else if (kind == 1) { pg8::Gemm g{HN, (const bf16*)(ws + WS_WBIN), M, 6144, DM, (size_t)BC_PAD * DM}; pg8::StaticOrder S; S.init(M, 6144, F.G, F.bx);
                pg8::EpiIn<1> E{l, 0};
                pg8::gemm_phase<pg8::EpiIn<1>, pg8::StaticOrder, true, true>(F.lds + RING_OFF, g, S, E, wv_);
                gate_rows<1>(HN, (const bf16*)(ws + WS_WBIN), (const long long*)(ws + WS_SS) + (size_t)(2 * l) * M, (const long long*)(ws + WS_BIAS) + BIAS_B, INF32(11) + (size_t)j * 32, (float*)(ws + WS_LF), nullptr, F.bx, F.G, wv_); }
            else { pg8::Gemm g{HN, (const bf16*)(ws + WS_WCIN), M, 6144, DM, (size_t)BC_PAD * DM}; pg8::StaticOrder S; S.init(M, 6144, F.G, F.bx);
                pg8::EpiIn<2> E{l, 0};
                pg8::gemm_phase<pg8::EpiIn<2>, pg8::StaticOrder, true, true>(F.lds + RING_OFF, g, S, E, wv_);
                gate_rows<2>(HN, (const bf16*)(ws + WS_WCIN), (const long long*)(ws + WS_SS) + (size_t)(2 * l) * M, (const long long*)(ws + WS_BIAS) + BIAS_C, INF32(14) + (size_t)j * 8, (float*)(ws + WS_GI), (float*)(ws + WS_LFC), F.bx, F.G, wv_); }
            } }
            if (IN(pb + 2)) { MKFRAME(); cargs_t ap = ARGS(); LOADP(); XcdBarrier b_; b_.bar = (unsigned*)(ap->ws + WS_CTL) + CW_BAR; b_.x = xb_xcc_id(); b_.st = (volatile LAS unsigned*)((LAS unsigned char*)lds + MISC_OFF) + 8;
                const BgList L = bg_list(l, F.bx, F.G, F.wave);
                xcd_barrier_bg(b_, P, ap, L, (LAS float*)(F.lds + RING_OFF + F.wave * 17408), F.wave, F.lane);
                if (kind == 0) bg_finish(P, ap, L, b_.st, (LAS float*)(F.lds + RING_OFF + F.wave * 17408), F.wave, F.lane); }
        }
        if (ON(3) && IN(pb + 2)) { for (int rep_ = 0; rep_ < REPS(3, kind); ++rep_) { if (rep_) GRIDBAR(); { MKFRAME(); cargs_t ap = ARGS(); unsigned char* ws = ap->ws;
            if (kind == 1) scan_phase(F, (const float*)(ws + WS_LF), 32, (float*)(ws + WS_FT));
            else if (kind == 2) {
#if USE_NAIVE_MLSTM
                scan_phase(F, (const float*)(ws + WS_LFC), 4, (float*)(ws + WS_FTC));
#else
                mls::m1_phase(F.lds + RING_OFF, (const bf16*)(ws + WS_Y), (const float*)(ws + WS_GI), (const float*)(ws + WS_LFC), (bf16*)(ws + WS_QF), (bf16*)(ws + WS_KF), (bf16*)(ws + WS_VF), (bf16*)(ws + WS_AF), (float*)(ws + WS_EG), F.vcu, F.G, wv_);
#endif
            }
            } } if (kind != 0) SEAM(pb + 2);
        }
        if (ON(4) && IN(pb + 3)) { for (int rep_ = 0; rep_ < REPS(4, kind); ++rep_) { if (rep_) GRIDBAR(); { MKFRAME(); cargs_t ap = ARGS(); unsigned char* ws = ap->ws; const bf16* Y = (const bf16*)(ws + WS_Y); bf16* AO = (bf16*)(ws + WS_AO);
            if (kind == 0) {
#if USE_NAIVE_SWA
                naive_mixer<0, 64, 64>(F, Y, A_IN, 0, 2048, 2304, 0, 32, 8, nullptr, nullptr, INF32(8) + (size_t)j * 32, AO);
#else
                fox_body::swa_phase((char*)lds + RING_OFF, (const fox_body::bf16*)Y, INF32(8) + (size_t)j * 32, (fox_body::bf16*)AO, F.vcu, F.G, (unsigned*)(ws + WS_CTL) + CW_SWAQ + 64 * j, wv_);
#endif
            }
            else if (kind == 1) {
#if USE_NAIVE_FOX
                naive_mixer<1, 64, 64>(F, Y, YLD, 0, 2048, 4096, 0, 32, 1, (const float*)(ws + WS_FT), nullptr, nullptr, AO);
#else
                static_assert(fox_body::ATTN_LDS_BYTES <= RING_BYTES, "attention LDS");
                const fox_body::AttnTensors AT{(const fox_body::bf16*)Y, (const fox_body::bf16*)(Y + 2048), (const fox_body::bf16*)(Y + 4096), (fox_body::bf16*)AO, (const float*)(ws + WS_FT), (const unsigned*)(ws + WS_QK2), (unsigned*)(ws + WS_CTL) + CW_QUEUE};
                fox_body::attn_phase<8>((char*)lds + RING_OFF, AT, wv_);
#endif
            }
            else {
#if USE_NAIVE_MLSTM
                naive_mixer<2, 256, 512>(F, Y, YLD, 0, 1024, 2048, 4096, 4, 1, (const float*)(ws + WS_FTC), (const float*)(ws + WS_GI), nullptr, AO);
#else
                static_assert(mls::M2_LDS_BYTES <= RING_BYTES, "mLSTM LDS");
                mls::m2_phase<0>(F.lds + RING_OFF, (char*)lds + RING_OFF, Y, (const bf16*)(ws + WS_QF), (const bf16*)(ws + WS_KF), (const bf16*)(ws + WS_VF), (const bf16*)(ws + WS_AF), (const float*)(ws + WS_EG), (float*)(ws + WS_CST), (float*)(ws + WS_EG) + 4096, AO, F.bx, F.G, wv_);
#endif
            }
            } } SEAM(pb + 3);
        }
        if (ON(4) && IN(pb + 4)) { if (kind == 2) { for (int rep_ = 0; rep_ < REPS(6, kind); ++rep_) { if (rep_) GRIDBAR(); MKFRAME(); cargs_t ap = ARGS(); unsigned char* ws = ap->ws;
                mls::m2_phase<1>(F.lds + RING_OFF, (char*)lds + RING_OFF, (const bf16*)(ws + WS_Y), (const bf16*)(ws + WS_QF), (const bf16*)(ws + WS_KF), (const bf16*)(ws + WS_VF), (const bf16*)(ws + WS_AF), (const float*)(ws + WS_EG), (float*)(ws + WS_CST), (float*)(ws + WS_EG) + 4096, (bf16*)(ws + WS_AO), F.bx, F.G, wv_);
                } SEAM(pb + 4); } }
        if (ON(5) && IN(pb + 5)) { for (int rep_ = 0; rep_ < REPS(5, kind); ++rep_) { if (rep_) GRIDBAR(); { MKFRAME(); cargs_t ap = ARGS(); unsigned char* ws = ap->ws;
            pg8::Gemm g{(const bf16*)(ws + WS_AO), (const bf16*)(ws + WS_WOUT) + (size_t)l * DM * DM, M, DM, DM, 0}; pg8::StaticOrder S; S.init(M, DM, F.G, F.bx);
            pg8::EpiRes E{l, 0, 0, (LAS float*)(F.lds + XCH_OFF)};
            pg8::gemm_phase<pg8::EpiRes, pg8::StaticOrder, true, true>(F.lds + RING_OFF, g, S, E, wv_);
            } } SEAM(pb + 5);
        }
        if (ON(7) && IN(pb + 6)) { for (int rep_ = 0; rep_ < REPS(7, kind); ++rep_) { if (rep_) GRIDBAR(); { MKFRAME(); cargs_t ap = ARGS(); unsigned char* ws = ap->ws;
            pg8::Gemm g{(const bf16*)(ws + WS_X1), (const bf16*)(ws + WS_WUP) + (size_t)l * 2 * NUP * DM, M, NUP, DM, (size_t)NUP * DM};     pg8::StaticOrder S; S.init(M, NUP, F.G, F.bx);
            pg8::EpiUp E{l, (LAS float*)(F.lds + XCH_OFF), (LAS float*)(F.lds + XCH_OFF + 8192)};
            pg8::gemm_phase<pg8::EpiUp, pg8::StaticOrder, true, true>(F.lds + RING_OFF, g, S, E, wv_);
            } } SEAM(pb + 6);
        }
        if (ON(8) && IN(pb + 7)) { for (int rep_ = 0; rep_ < REPS(8, kind); ++rep_) { if (rep_) GRIDBAR(); { MKFRAME(); cargs_t ap = ARGS(); unsigned char* ws = ap->ws; fixup_phase(F, (const float*)(ws + WS_HU), INF32(17) + (size_t)l * 3 * NUP, INF32(18) + (size_t)l * NUP, (bf16*)(ws + WS_ACT)); } } SEAM(pb + 7); }
        if (ON(9) && IN(pb + 8)) { for (int rep_ = 0; rep_ < REPS(9, kind); ++rep_) { if (rep_) GRIDBAR(); { MKFRAME(); cargs_t ap = ARGS(); unsigned char* ws = ap->ws;
            pg8::Gemm g{(const bf16*)(ws + WS_ACT), (const bf16*)(ws + WS_WDN) + (size_t)l * DM * DFF, M, DM, DFF, 0}; pg8::StaticOrder S; S.init(M, DM, F.G, F.bx);
            pg8::EpiRes E{l, 1, 0, (LAS float*)(F.lds + XCH_OFF)};
            pg8::gemm_phase<pg8::EpiRes, pg8::StaticOrder, true, true>(F.lds + RING_OFF, g, S, E, wv_);
            } } SEAM(pb + 8);
        }
    }
    if (ON(10) && IN(PH_FINAL)) { MKFRAME(); cargs_t ap = ARGS(); final_norm_phase(F, (const bf16*)(ap->ws + WS_HN), (const long long*)(ap->ws + WS_SS) + (size_t)8 * M, INF32(6), ap->out); }
#undef IN
#undef SEAM
}

#ifndef MK_ONE_LAUNCH
#define MK_ONE_LAUNCH 1
#endif
extern "C" void kernel_launch(void* const* d_in, const int* in_sizes, int n_in, void* d_out, int out_size, void* d_ws, size_t ws_size, hipStream_t stream) {
    static int grid = 0;
    if (grid == 0) {
        if (n_in != 20 || in_sizes[0] != M * DM || out_size != M * DM || ws_size < WS_END) { fprintf(stderr, "kernel_launch: unexpected shapes (n_in %d, in0 %d, out %d, ws %zu < %zu); nothing launched\n", n_in, n_in > 0 ? in_sizes[0] : -1, out_size, ws_size, (size_t)WS_END); grid = -1; return; }
        int dev = 0, cus = 0, per_cu = 0;
        if (hipGetDevice(&dev) != hipSuccess || hipDeviceGetAttribute(&cus, hipDeviceAttributeMultiprocessorCount, dev) != hipSuccess) { grid = -1; return; }
        if (hipFuncSetAttribute((const void*)fwd_kernel, hipFuncAttributeMaxDynamicSharedMemorySize, LDS_BYTES) != hipSuccess) { fprintf(stderr, "kernel_launch: hipFuncSetAttribute failed\n"); grid = -1; return; }
        if (hipOccupancyMaxActiveBlocksPerMultiprocessor(&per_cu, (const void*)fwd_kernel, NWAVES * 64, LDS_BYTES) != hipSuccess || per_cu < 1) fprintf(stderr, "kernel_launch: occupancy query reports %d\n", per_cu);
        (void)hipGetLastError();
        grid = cus;
    }
    if (grid < 0) return;
    (void)hipMemsetAsync((char*)d_ws + WS_CTL, 0, CTL_ZERO_BYTES, stream);
    Args a{};
    for (int i = 0; i < 20; ++i) a.in[i] = d_in[i];
    a.out = (float*)d_out; a.ws = (unsigned char*)d_ws;
#if MK_ONE_LAUNCH
    a.ph_lo = 0; a.ph_hi = PH_END;
    hipLaunchKernelGGL(fwd_kernel, dim3(grid), dim3(NWAVES * 64), LDS_BYTES, stream, a);
#else
    for (int ph = 0; ph < PH_END; ++ph) {
        if (ph >= PH_L0 && ph < PH_FINAL) { const int l = (ph - PH_L0) / 10, k = (ph - PH_L0) % 10; if (k == 9 || k == 0 || k == 5 || (k == 2 && (l % 3) == 0)) continue; }
        a.ph_lo = ph; a.ph_hi = ph + 1;
        hipLaunchKernelGGL(fwd_kernel, dim3(grid), dim3(NWAVES * 64), LDS_BYTES, stream, a);
    }
#endif
}
```
